# Optimizing an MI355X kernel written in HIP

```python
import math
import jax, jax.numpy as jnp
from jax import lax
import numpy as np

D_MODEL = 1024
BATCH = 4
SEQ = 8192
DEPTH = 2

N_A = DEPTH // 2
N_B = DEPTH - N_A
CHUNK = 128
GMLP_WIDTH = 2 * D_MODEL
GMLP_GROUPS = 8
GMLP_GROUP_DIM = GMLP_WIDTH // GMLP_GROUPS
DIFF_HEADS = 8
DIFF_HEAD_DIM = D_MODEL // (2 * DIFF_HEADS)
DIFF_V_DIM = 2 * DIFF_HEAD_DIM
D_K = DIFF_HEADS * 2 * DIFF_HEAD_DIM
D_V = DIFF_HEADS * DIFF_V_DIM
ROT_DIM = DIFF_HEAD_DIM // 4
ROPE_THETA = 500000.0
Q_BLOCK = 128
D_FF = -(-(8 * D_MODEL) // (3 * 256)) * 256
EPS = 1e-5

kernel_name = "yoco_gmlp_diffattn_hybrid"


def rmsnorm(x, g):
    x32 = x.astype(jnp.float32)
    y = x32 * lax.rsqrt(jnp.mean(x32 * x32, axis=-1, keepdims=True) + EPS)
    return (y * g.astype(jnp.float32)).astype(x.dtype)


def layernorm(x, g, b):
    x32 = x.astype(jnp.float32)
    mu = jnp.mean(x32, axis=-1, keepdims=True)
    xc = x32 - mu
    y = xc * lax.rsqrt(jnp.mean(xc * xc, axis=-1, keepdims=True) + EPS)
    return (y * g.astype(jnp.float32) + b.astype(jnp.float32)).astype(x.dtype)


def rope_partial(x, pos):
    half = ROT_DIM // 2
    inv_freq = jnp.power(ROPE_THETA, -jnp.arange(half, dtype=jnp.float32) * 2.0 / ROT_DIM)
    ang = pos.astype(jnp.float32)[:, None] * inv_freq[None, :]
    cos = jnp.cos(ang)[:, None, None, :]
    sin = jnp.sin(ang)[:, None, None, :]
    xr = x[..., :ROT_DIM].astype(jnp.float32)
    x1, x2 = xr[..., :half], xr[..., half:]
    rot = jnp.concatenate([x1 * cos - x2 * sin, x2 * cos + x1 * sin], axis=-1)
    return jnp.concatenate([rot.astype(x.dtype), x[..., ROT_DIM:]], axis=-1)


def gmlp_mixer(h, w_in, ln_g, ln_b, w_s, b_s, w_out):
    B, S, _ = h.shape
    z = jax.nn.gelu(h @ w_in, approximate=False)
    u, v = jnp.split(z, 2, axis=-1)
    v = layernorm(v, ln_g, ln_b)
    n_chunks = S // CHUNK
    v = v.reshape(B, n_chunks, CHUNK, GMLP_GROUPS, GMLP_GROUP_DIM)
    causal = jnp.tril(jnp.ones((CHUNK, CHUNK), dtype=bool))
    ws = jnp.where(causal[None], w_s, 0).astype(v.dtype)
    mixed = jnp.einsum('gts,bcsgd->bctgd', ws, v) + b_s.T.astype(v.dtype)[None, None, :, :, None]
    gated = u * mixed.reshape(B, S, GMLP_WIDTH)
    return gated @ w_out


def shared_kv(h, kv_norm_g, w_kv, pos):
    B, S, _ = h.shape
    kv = rmsnorm(h, kv_norm_g) @ w_kv
    k, v = jnp.split(kv, [D_K], axis=-1)
    k = rope_partial(k.reshape(B, S, DIFF_HEADS, 2, DIFF_HEAD_DIM), pos)
    v = v.reshape(B, S, DIFF_HEADS, DIFF_V_DIM)
    return k, v


def diff_attention(h, k, v, pos, w_q, lam_q, lam_k, sub_g, w_o, lam_init):
    B, S, _ = h.shape
    q = rope_partial((h @ w_q).reshape(B, S, DIFF_HEADS, 2, DIFF_HEAD_DIM), pos)
    lq = lam_q.astype(jnp.float32)
    lk = lam_k.astype(jnp.float32)
    lam = jnp.exp(jnp.sum(lq[0] * lk[0])) - jnp.exp(jnp.sum(lq[1] * lk[1])) + lam_init
    n_blocks = S // Q_BLOCK
    qb = q.reshape(B, n_blocks, Q_BLOCK, DIFF_HEADS, 2, DIFF_HEAD_DIM).transpose(1, 0, 2, 3, 4, 5)
    k_pos = jnp.arange(S, dtype=jnp.int32)
    scale = DIFF_HEAD_DIM ** -0.5

    def block(args):
        q_blk, i = args
        q_pos = i * Q_BLOCK + jnp.arange(Q_BLOCK, dtype=jnp.int32)
        s = jnp.einsum('bqhcd,bkhcd->bhcqk', q_blk, k).astype(jnp.float32) * scale
        s = jnp.where(k_pos[None, :] <= q_pos[:, None], s, -jnp.inf)
        p = jax.nn.softmax(s, axis=-1)
        a = p[:, :, 0] - lam * p[:, :, 1]
        return jnp.einsum('bhqk,bkhe->bqhe', a.astype(v.dtype), v)

    o = lax.map(block, (qb, jnp.arange(n_blocks, dtype=jnp.int32)))
    o = o.transpose(1, 0, 2, 3, 4).reshape(B, S, DIFF_HEADS, DIFF_V_DIM)
    o = rmsnorm(o, sub_g) * (1.0 - lam_init)
    return o.reshape(B, S, D_V) @ w_o


def swiglu(h, w_gu, w_down):
    gate, up = jnp.split(h @ w_gu, 2, axis=-1)
    return (jax.nn.silu(gate) * up) @ w_down


def setup_inputs(seed: int = 0) -> dict:
    key = jax.random.key(seed)
    ks = jax.random.split(key, 20)
    f32 = jnp.float32
    nrm = lambda k, shape, s: jax.random.normal(k, shape, f32) * s
    return {
        "x": nrm(ks[0], (BATCH, SEQ, D_MODEL), 1.0),
        "attn_norm_g": 1.0 + nrm(ks[1], (DEPTH, D_MODEL), 0.02),
        "ffn_norm_g": 1.0 + nrm(ks[2], (DEPTH, D_MODEL), 0.02),
        "gmlp_w_in": nrm(ks[3], (N_A, D_MODEL, 2 * GMLP_WIDTH), D_MODEL ** -0.5),
        "gmlp_ln_g": 1.0 + nrm(ks[4], (N_A, GMLP_WIDTH), 0.02),
        "gmlp_ln_b": nrm(ks[5], (N_A, GMLP_WIDTH), 0.02),
        "gmlp_w_s": nrm(ks[6], (N_A, GMLP_GROUPS, CHUNK, CHUNK), CHUNK ** -0.5),
        "gmlp_b_s": 1.0 + nrm(ks[7], (N_A, GMLP_GROUPS, CHUNK), 0.1),
        "gmlp_w_out": nrm(ks[8], (N_A, GMLP_WIDTH, D_MODEL), GMLP_WIDTH ** -0.5),
        "kv_norm_g": 1.0 + nrm(ks[9], (D_MODEL,), 0.02),
        "w_kv": nrm(ks[10], (D_MODEL, D_K + D_V), D_MODEL ** -0.5),
        "diff_w_q": nrm(ks[11], (N_B, D_MODEL, D_K), D_MODEL ** -0.5),
        "diff_lambda_q": nrm(ks[12], (N_B, 2, DIFF_HEAD_DIM), 0.1),
        "diff_lambda_k": nrm(ks[13], (N_B, 2, DIFF_HEAD_DIM), 0.1),
        "diff_sub_g": 1.0 + nrm(ks[14], (N_B, DIFF_V_DIM), 0.02),
        "diff_w_o": nrm(ks[15], (N_B, D_V, D_MODEL), D_V ** -0.5),
        "ffn_w_gu": nrm(ks[16], (DEPTH, D_MODEL, 2 * D_FF), D_MODEL ** -0.5),
        "ffn_w_down": nrm(ks[17], (DEPTH, D_FF, D_MODEL), D_FF ** -0.5),
        "final_norm_g": 1.0 + nrm(ks[18], (D_MODEL,), 0.02),
    }


def reference(x, attn_norm_g, ffn_norm_g, gmlp_w_in, gmlp_ln_g, gmlp_ln_b, gmlp_w_s, gmlp_b_s,
              gmlp_w_out, kv_norm_g, w_kv, diff_w_q, diff_lambda_q, diff_lambda_k, diff_sub_g,
              diff_w_o, ffn_w_gu, ffn_w_down, final_norm_g):
    S = x.shape[1]
    pos = jnp.arange(S, dtype=jnp.int32)
    h = x
    k_sh, v_sh = None, None
    for l in range(DEPTH):
        hn = rmsnorm(h, attn_norm_g[l])
        if l < N_A:
            a = l
            h = h + gmlp_mixer(hn, gmlp_w_in[a], gmlp_ln_g[a], gmlp_ln_b[a], gmlp_w_s[a],
                               gmlp_b_s[a], gmlp_w_out[a])
        else:
            b = l - N_A
            lam_init = 0.8 - 0.6 * math.exp(-0.3 * l)
            h = h + diff_attention(hn, k_sh, v_sh, pos, diff_w_q[b], diff_lambda_q[b],
                                   diff_lambda_k[b], diff_sub_g[b], diff_w_o[b], lam_init)
        h = h + swiglu(rmsnorm(h, ffn_norm_g[l]), ffn_w_gu[l], ffn_w_down[l])
        if l == N_A - 1:
            k_sh, v_sh = shared_kv(h, kv_norm_g, w_kv, pos)
    return rmsnorm(h, final_norm_g)
```

```cpp
#include <hip/hip_runtime.h>
#include <hip/hip_cooperative_groups.h>
#include <cstdio>
#include <cstdint>
namespace cg = cooperative_groups;
constexpr int NBATCH = 4, SEQLEN = 8192, DMODEL = 1024, MROWS = NBATCH * SEQLEN;
constexpr int GWIDTH = 2048, DFF = 2816;
constexpr float NORM_EPS = 1e-5f;
constexpr float LAM_INIT = 0.35550906759096934f;
constexpr float QSCALE = 0.125f * 1.4426950408889634f;
namespace pg8 {
#define PG8_LAS __attribute__((address_space(3)))
typedef unsigned short bf16_t;
typedef short bf16x8 __attribute__((ext_vector_type(8)));
typedef float f32x4 __attribute__((ext_vector_type(4)));
typedef unsigned u32x4 __attribute__((ext_vector_type(4)));
constexpr int BM = 256, BK = 64, HALF = 128, HTB = HALF * BK * 2  , STAGE_BYTES = 8 * HTB, NXCD = 8, WGM = 8;

__host__ __device__ __forceinline__ int lds_byte(int r, int c) { const int st = (r >> 4) * 2 + (c >> 5), rr = r & 15, cc = c & 31, ob = rr * 64 + cc * 2; return st * 1024 + (ob ^ (((ob >> 9) & 1) << 5)); }
__host__ __device__ __forceinline__ void stage_rc(int b, int& R, int& C) { const int st = b / 1024, sb = b % 1024, swz = sb ^ (((sb >> 9) & 1) << 5); R = (st >> 1) * 16 + swz / 64; C = (st & 1) * 32 + (swz % 64) / 2; }
__host__ __device__ __forceinline__ int perm32(int rho) { const int n = rho >> 4, i = rho & 15; return 8 * (i >> 2) + 4 * n + (i & 3); }

struct Unit { int pm, pn; };
struct Gemm { const bf16_t* A; const bf16_t* Bt; int M, N, K; };

struct StaticOrder {
    int nM, nN, nwg, G, c;
    __host__ __device__ void init(int M, int N, int G_, int c_) { nM = M / BM; nN = N / BM; nwg = nM * nN; G = G_; c = c_; }
    __host__ __device__ bool next(int i, Unit& u) const {
        const long L = (long)i * G + c; if (L >= nwg) return false;
        int wgid = (int)L; { const int q = nwg / NXCD, r = nwg % NXCD, xcd = wgid % NXCD, off = wgid / NXCD; wgid = (xcd < r ? xcd * (q + 1) : r * (q + 1) + (xcd - r) * q) + off; }
        const int nig = WGM * nN, gid = wgid / nig, fm = gid * WGM, gsz = (nM - fm) < WGM ? (nM - fm) : WGM;
        u.pm = fm + ((wgid % nig) % gsz); u.pn = (wgid % nig) / gsz; return true;
    }
    __device__ __forceinline__ void a_ready(const Unit&) const {}
    __device__ __forceinline__ void done(const Unit&) const {}
};

__device__ __forceinline__ unsigned cvt_pk_bf16(float lo, float hi) { unsigned r; asm volatile("v_cvt_pk_bf16_f32 %0, %1, %2" : "=v"(r) : "v"(lo), "v"(hi)); return r; }
typedef float f32x2 __attribute__((ext_vector_type(2)));
__device__ __forceinline__ f32x2 gelu_pk(f32x2 v) {
    const f32x2 av = __builtin_elementwise_abs(v), d = av * 0.2316418882f + 1.0f;
    f32x2 t; t.x = __builtin_amdgcn_rcpf(d.x); t.y = __builtin_amdgcn_rcpf(d.y);
    f32x2 q = t * 0.5307027145f + (-0.7265760135f); q = q * t + 0.7107068705f; q = q * t + (-0.142248368f); q = q * t + 0.127414796f; q = q * t;
    const f32x2 s = (v * v) * (-0.72134752044f);
    f32x2 e; e.x = __builtin_amdgcn_exp2f(s.x); e.y = __builtin_amdgcn_exp2f(s.y);
    const f32x2 m = v * (q * e), r = v - m;
    f32x2 o; o.x = v.x < 0.f ? m.x : r.x; o.y = v.y < 0.f ? m.y : r.y; return o;
}

template <int ACT  > struct EpiBf16 {
    static constexpr bool PERM = true, AFTER_DRAIN = false; static_assert(ACT == 0 || ACT == 1, "EpiBf16: ACT is 0 (none) or 1 (gelu_pk)");
    bf16_t* O; int ldc; const float* bias; int split_cols; size_t split_stride; float scale0;
    __device__ __forceinline__ void operator()(const f32x4 (&acc)[2][2][4][2], const Unit& u, int wr, int wc, int fr, int fq) const {
        const int row0 = u.pm * BM + wr * 64 + fr; int colt = u.pn * BM; bf16_t* base = O;
        float sc = 1.f; if (split_cols) { const int t = colt / split_cols; base += (size_t)t * split_stride; colt -= t * split_cols; if (t == 0) sc = scale0; }
        const int col0 = colt + wc * 32 + 8 * fq, bcol0 = u.pn * BM + wc * 32 + 8 * fq;
        f32x4 bv[2][2];
#pragma unroll
        for (int bj = 0; bj < 2; ++bj)
#pragma unroll
            for (int n = 0; n < 2; ++n) bv[bj][n] = bias ? *(const f32x4*)(bias + bcol0 + bj * HALF + 4 * n) : (f32x4){0.f, 0.f, 0.f, 0.f};
#pragma unroll
        for (int ai = 0; ai < 2; ++ai)
#pragma unroll
            for (int m = 0; m < 4; ++m) { bf16_t* rowp = base + (size_t)(row0 + ai * HALF + m * 16) * ldc + col0;
#pragma unroll
                for (int bj = 0; bj < 2; ++bj) { f32x4 v0 = acc[ai][bj][m][0] + bv[bj][0], v1 = acc[ai][bj][m][1] + bv[bj][1];
                    if (ACT == 1) { f32x2 a = gelu_pk((f32x2){v0[0], v0[1]}), b = gelu_pk((f32x2){v0[2], v0[3]}), c = gelu_pk((f32x2){v1[0], v1[1]}), d = gelu_pk((f32x2){v1[2], v1[3]});
                        v0 = (f32x4){a.x, a.y, b.x, b.y}; v1 = (f32x4){c.x, c.y, d.x, d.y}; }
                    v0 = v0 * sc; v1 = v1 * sc; u32x4 w; w.x = cvt_pk_bf16(v0[0], v0[1]); w.y = cvt_pk_bf16(v0[2], v0[3]); w.z = cvt_pk_bf16(v1[0], v1[1]); w.w = cvt_pk_bf16(v1[2], v1[3]);
                    *(u32x4*)(rowp + bj * HALF) = w; } }
    }
};
typedef float f32x2e __attribute__((ext_vector_type(2)));
__device__ __forceinline__ float bf_lo(unsigned w) { return __uint_as_float(w << 16); }
__device__ __forceinline__ float bf_hi(unsigned w) { return __uint_as_float(w & 0xffff0000u); }
struct EpiGeluUV {
    static constexpr bool PERM = true, AFTER_DRAIN = false;
    bf16_t* UV; float* lns;
    __device__ __forceinline__ void operator()(const f32x4 (&acc)[2][2][4][2], const Unit& u, int wr, int wc, int fr, int fq) const {
        const int isv = (u.pn >= 8) ? 1 : 0, pn = u.pn - 8 * isv;
        const int row0 = u.pm * BM + wr * 64 + fr, col0 = pn * BM + wc * 32 + 8 * fq;
        bf16_t* base = UV + (size_t)isv * ((size_t)MROWS * GWIDTH);
#pragma unroll
        for (int ai = 0; ai < 2; ++ai)
#pragma unroll
            for (int m = 0; m < 4; ++m) {
                const int row = row0 + ai * HALF + m * 16;
                bf16_t* rowp = base + (size_t)row * GWIDTH + col0;
                float s = 0.f, q = 0.f;
#pragma unroll
                for (int bj = 0; bj < 2; ++bj) {
                    const f32x4 v0 = acc[ai][bj][m][0], v1 = acc[ai][bj][m][1];
                    const f32x2 a = gelu_pk((f32x2){v0[0], v0[1]}), b = gelu_pk((f32x2){v0[2], v0[3]}), c = gelu_pk((f32x2){v1[0], v1[1]}), d = gelu_pk((f32x2){v1[2], v1[3]});
                    u32x4 w; w.x = cvt_pk_bf16(a.x, a.y); w.y = cvt_pk_bf16(b.x, b.y); w.z = cvt_pk_bf16(c.x, c.y); w.w = cvt_pk_bf16(d.x, d.y);
                    *(u32x4*)(rowp + bj * HALF) = w;
                    if (isv) {
                        const float e0 = bf_lo(w.x), e1 = bf_hi(w.x), e2 = bf_lo(w.y), e3 = bf_hi(w.y), e4 = bf_lo(w.z), e5 = bf_hi(w.z), e6 = bf_lo(w.w), e7 = bf_hi(w.w);
                        s += ((e0 + e1) + (e2 + e3)) + ((e4 + e5) + (e6 + e7));
                        q += ((e0 * e0 + e1 * e1) + (e2 * e2 + e3 * e3)) + ((e4 * e4 + e5 * e5) + (e6 * e6 + e7 * e7));
                    }
                }
                if (isv) {
                    s += __shfl_xor(s, 16); s += __shfl_xor(s, 32); q += __shfl_xor(q, 16); q += __shfl_xor(q, 32);
                    if (fq == 0) *(f32x2e*)(lns + (size_t)row * 64 + (pn * 4 + wc) * 2) = (f32x2e){s, q};
                }
            }
    }
};
template <bool BASE_F32, bool OUT_F32> struct EpiRes {
    static constexpr bool PERM = true, AFTER_DRAIN = false;
    const float* basef; const bf16_t* baseh; float* outf; bf16_t* outh; float* rms;
    __device__ __forceinline__ void operator()(const f32x4 (&acc)[2][2][4][2], const Unit& u, int wr, int wc, int fr, int fq) const {
        const int row0 = u.pm * BM + wr * 64 + fr, col0 = u.pn * BM + wc * 32 + 8 * fq;
        constexpr int MB = BASE_F32 ? 2 : 8;
#pragma unroll
        for (int g = 0; g < 8; g += MB) {
            f32x4 pf[MB][2][2]; u32x4 ph[MB][2];
#pragma unroll
            for (int k = 0; k < MB; ++k) { const int ai = (g + k) >> 2, m = (g + k) & 3; const size_t off = (size_t)(row0 + ai * HALF + m * 16) * DMODEL + col0;
#pragma unroll
                for (int bj = 0; bj < 2; ++bj) {
                    if (BASE_F32) { pf[k][bj][0] = *(const f32x4*)(basef + off + bj * HALF); pf[k][bj][1] = *(const f32x4*)(basef + off + bj * HALF + 4); }
                    else ph[k][bj] = *(const u32x4*)(baseh + off + bj * HALF); } }
            asm volatile("" ::: "memory");
#pragma unroll
            for (int k = 0; k < MB; ++k) {
                const int ai = (g + k) >> 2, m = (g + k) & 3;
                const int row = row0 + ai * HALF + m * 16; const size_t off = (size_t)row * DMODEL + col0;
                float q = 0.f;
#pragma unroll
                for (int bj = 0; bj < 2; ++bj) {
                    f32x4 b0, b1;
                    if (BASE_F32) { b0 = pf[k][bj][0]; b1 = pf[k][bj][1]; }
                    else { const u32x4 w = ph[k][bj]; b0 = (f32x4){bf_lo(w.x), bf_hi(w.x), bf_lo(w.y), bf_hi(w.y)}; b1 = (f32x4){bf_lo(w.z), bf_hi(w.z), bf_lo(w.w), bf_hi(w.w)}; }
                    const f32x4 o0 = b0 + acc[ai][bj][m][0], o1 = b1 + acc[ai][bj][m][1];
                    q += ((o0[0] * o0[0] + o0[1] * o0[1]) + (o0[2] * o0[2] + o0[3] * o0[3])) + ((o1[0] * o1[0] + o1[1] * o1[1]) + (o1[2] * o1[2] + o1[3] * o1[3]));
                    if (OUT_F32) { *(f32x4*)(outf + off + bj * HALF) = o0; *(f32x4*)(outf + off + bj * HALF + 4) = o1; }
                    else { u32x4 w; w.x = cvt_pk_bf16(o0[0], o0[1]); w.y = cvt_pk_bf16(o0[2], o0[3]); w.z = cvt_pk_bf16(o1[0], o1[1]); w.w = cvt_pk_bf16(o1[2], o1[3]); *(u32x4*)(outh + off + bj * HALF) = w; }
                }
                q += __shfl_xor(q, 16); q += __shfl_xor(q, 32);
                if (fq == 0) rms[(size_t)row * 16 + u.pn * 4 + wc] = q;
            }
            asm volatile("" ::: "memory");
        }
    }
};
__device__ __forceinline__ float row_rstd(const float* rms, int row) {
    const f32x4* rp = (const f32x4*)(rms + (size_t)row * 16);
    const f32x4 a = rp[0], b = rp[1], c = rp[2], d = rp[3];
    const float ss = ((a[0] + a[1]) + (a[2] + a[3])) + ((b[0] + b[1]) + (b[2] + b[3])) + ((c[0] + c[1]) + (c[2] + c[3])) + ((d[0] + d[1]) + (d[2] + d[3]));
    return 1.0f / sqrtf(ss * (1.0f / DMODEL) + NORM_EPS);
}
__device__ __forceinline__ float row_rstd_q(const float* rms, int row, int fq) {
    const f32x4 a = *(const f32x4*)(rms + (size_t)row * 16 + fq * 4);
    float ss = (a[0] + a[1]) + (a[2] + a[3]); ss += __shfl_xor(ss, 16); ss += __shfl_xor(ss, 32);
    return 1.0f / sqrtf(ss * (1.0f / DMODEL) + NORM_EPS);
}
struct EpiSwiglu {
    static constexpr bool PERM = true, AFTER_DRAIN = false;
    bf16_t* act; const float* rms;
    __device__ __forceinline__ void operator()(const f32x4 (&acc)[2][2][4][2], const Unit& u, int wr, int wc, int fr, int fq) const {
        const int row0 = u.pm * BM + wr * 64 + fr, col0 = u.pn * HALF + wc * 32 + 8 * fq;
        float rs_[2][4];
#pragma unroll
        for (int ai = 0; ai < 2; ++ai)
#pragma unroll
            for (int m = 0; m < 4; ++m) rs_[ai][m] = row_rstd_q(rms, row0 + ai * HALF + m * 16, fq);
#pragma unroll
        for (int ai = 0; ai < 2; ++ai)
#pragma unroll
            for (int m = 0; m < 4; ++m) {
                const int row = row0 + ai * HALF + m * 16; const float rstd = rs_[ai][m];
                float o[8];
#pragma unroll
                for (int n = 0; n < 2; ++n)
#pragma unroll
                    for (int e = 0; e < 4; ++e) { const float g = acc[ai][0][m][n][e] * rstd, up = acc[ai][1][m][n][e] * rstd;
                        const float sg = g * __builtin_amdgcn_rcpf(1.0f + __builtin_amdgcn_exp2f(-1.4426950408889634f * g)); o[n * 4 + e] = sg * up; }
                u32x4 w; w.x = cvt_pk_bf16(o[0], o[1]); w.y = cvt_pk_bf16(o[2], o[3]); w.z = cvt_pk_bf16(o[4], o[5]); w.w = cvt_pk_bf16(o[6], o[7]);
                *(u32x4*)(act + (size_t)row * DFF + col0) = w;
            }
    }
};
struct EpiKVQ {
    static constexpr bool PERM = true, AFTER_DRAIN = false;
    bf16_t* KVQ; const float* rms; const float* rope;
    __device__ __forceinline__ void operator()(const f32x4 (&acc)[2][2][4][2], const Unit& u, int wr, int wc, int fr, int fq) const {
        const int t = u.pn >> 2, colt = (u.pn & 3) * BM;
        const int row0 = u.pm * BM + wr * 64 + fr, col0 = colt + wc * 32 + 8 * fq;
        bf16_t* base = KVQ + (size_t)t * ((size_t)MROWS * DMODEL);
        const float sc = (t == 2) ? QSCALE : 1.0f;
        const bool roped = (t != 1) && ((wc & 1) == 0);
        float rs_[2][4];
#pragma unroll
        for (int ai = 0; ai < 2; ++ai)
#pragma unroll
            for (int m = 0; m < 4; ++m) rs_[ai][m] = row_rstd_q(rms, row0 + ai * HALF + m * 16, fq);
#pragma unroll
        for (int ai = 0; ai < 2; ++ai)
#pragma unroll
            for (int m = 0; m < 4; ++m) {
                const int row = row0 + ai * HALF + m * 16; const float rstd = rs_[ai][m];
                f32x4 c0 = {1.f, 1.f, 1.f, 1.f}, c1 = c0, s0 = {0.f, 0.f, 0.f, 0.f}, s1 = s0;
                if (roped && fq < 2) { const float* rp = rope + (size_t)(row & (SEQLEN - 1)) * 16;
                    c0 = *(const f32x4*)rp; c1 = *(const f32x4*)(rp + 4); s0 = *(const f32x4*)(rp + 8); s1 = *(const f32x4*)(rp + 12);
                    if (fq == 0) { s0 = -s0; s1 = -s1; } }
#pragma unroll
                for (int bj = 0; bj < 2; ++bj) {
                    f32x4 v0 = acc[ai][bj][m][0] * rstd, v1 = acc[ai][bj][m][1] * rstd;
                    if (roped) { f32x4 p0, p1;
#pragma unroll
                        for (int e = 0; e < 4; ++e) { p0[e] = __shfl_xor(v0[e], 16); p1[e] = __shfl_xor(v1[e], 16); }
                        v0 = v0 * c0 + p0 * s0; v1 = v1 * c1 + p1 * s1; }
                    v0 = v0 * sc; v1 = v1 * sc;
                    u32x4 w; w.x = cvt_pk_bf16(v0[0], v0[1]); w.y = cvt_pk_bf16(v0[2], v0[3]); w.z = cvt_pk_bf16(v1[0], v1[1]); w.w = cvt_pk_bf16(v1[2], v1[3]);
                    *(u32x4*)(base + (size_t)row * DMODEL + col0 + bj * HALF) = w;
                }
            }
    }
};

template <class Epi, class Sched, bool ALIGN_EPI = false, bool SP2 = false>
__device__ __forceinline__ void gemm_phase(PG8_LAS unsigned char* lds, const Gemm g, const Sched& S, const Epi& E) {
    int tid_ = threadIdx.x; asm volatile("" : "+v"(tid_));
    const int tid = tid_, wid = __builtin_amdgcn_readfirstlane(tid >> 6), lane = tid & 63, wr = wid >> 2, wc = wid & 3, fr = lane & 15, fq = lane >> 4;
    const int K = g.K, nt = K / BK;
    unsigned voffA[2], voffB[2];
#pragma unroll
    for (int i = 0; i < 2; ++i) { int R, C; stage_rc(tid * 16 + i * 8192, R, C); const int Rb = Epi::PERM ? ((R & ~31) + perm32(R & 31)) : R;
        voffA[i] = (unsigned)(R * K + C) * 2u; voffB[i] = (unsigned)(Rb * K + C) * 2u; }
    const size_t kstep = (size_t)(BK * 2);
    const size_t hstep = (size_t)HALF * K * 2;
    const size_t tstep = 2 * hstep;
    const unsigned ldsw = (unsigned)wid * 1024u;
    const int aoff = lds_byte(wr * 64 + fr, fq * 8), boff = lds_byte(wc * 32 + fr, fq * 8);
#define PG8_SA(b, h) (((b) * 2 + (h)) * HTB)
#define PG8_SB(b, h) ((4 + (b) * 2 + (h)) * HTB)
#define PG8_STAGE(bufoff, gbase, voff) do { _Pragma("unroll") for (int _i = 0; _i < 2; ++_i) \
        __builtin_amdgcn_global_load_lds((const unsigned*)((const char*)(gbase) + (voff)[_i]), (PG8_LAS unsigned*)(lds + (bufoff) + ldsw + _i * 8192), 16, 0, 0); } while (0)
#define PG8_LDA(dst, b, h) do { _Pragma("unroll") for (int m = 0; m < 4; ++m) _Pragma("unroll") for (int k = 0; k < 2; ++k) dst[m][k] = *(const PG8_LAS bf16x8*)(lds + PG8_SA(b, h) + aoff + m * 2048 + k * 1024); } while (0)
#define PG8_LDB(dst, b, h) do { _Pragma("unroll") for (int n = 0; n < 2; ++n) _Pragma("unroll") for (int k = 0; k < 2; ++k) dst[n][k] = *(const PG8_LAS bf16x8*)(lds + PG8_SB(b, h) + boff + n * 2048 + k * 1024); } while (0)
#define PG8_MMA(ai, bj, At, Bt) do { __builtin_amdgcn_s_setprio(1); _Pragma("unroll") for (int m = 0; m < 4; ++m) _Pragma("unroll") for (int n = 0; n < 2; ++n) _Pragma("unroll") for (int k = 0; k < 2; ++k) \
        acc[ai][bj][m][n] = __builtin_amdgcn_mfma_f32_16x16x32_bf16(Bt[n][k], At[m][k], acc[ai][bj][m][n], 0, 0, 0); __builtin_amdgcn_s_setprio(0); } while (0)
#define PG8_WAIT_V(n) asm volatile("s_waitcnt vmcnt(" #n ")" ::: "memory")
#define PG8_WAIT_L(n) asm volatile("s_waitcnt lgkmcnt(" #n ")" ::: "memory")
#define PG8_BAR __builtin_amdgcn_s_barrier()
#define PG8_SCHED __builtin_amdgcn_sched_barrier(0)
    Unit cur, nxt; int ui = 0;
    if (!S.next(0, cur)) return;
    f32x4 acc[2][2][4][2];
#pragma unroll
    for (int a = 0; a < 2; ++a)
#pragma unroll
        for (int b = 0; b < 2; ++b)
#pragma unroll
            for (int m = 0; m < 4; ++m)
#pragma unroll
                for (int n = 0; n < 2; ++n) acc[a][b][m][n] = (f32x4){0.f, 0.f, 0.f, 0.f};
    bf16x8 At[4][2], B0[2][2], B1[2][2];
    const char* cA = (const char*)g.A + (size_t)cur.pm * tstep; const char* cB = (const char*)g.Bt + (size_t)cur.pn * tstep;
    S.a_ready(cur);
    if constexpr (SP2) {
        PG8_STAGE(PG8_SB(0, 0), cB, voffB); PG8_STAGE(PG8_SB(0, 1), cB + hstep, voffB); PG8_STAGE(PG8_SA(0, 0), cA, voffA); PG8_STAGE(PG8_SA(0, 1), cA + hstep, voffA);
        if (wr == 1) PG8_BAR;
        PG8_WAIT_V(2); PG8_BAR;
        PG8_STAGE(PG8_SB(1, 0), cB + kstep, voffB); PG8_STAGE(PG8_SA(1, 0), cA + kstep, voffA); PG8_STAGE(PG8_SB(1, 1), cB + hstep + kstep, voffB);
        PG8_WAIT_V(6); PG8_BAR;
    } else {
        PG8_STAGE(PG8_SB(0, 0), cB, voffB); PG8_STAGE(PG8_SA(0, 0), cA, voffA); PG8_STAGE(PG8_SB(0, 1), cB + hstep, voffB); PG8_STAGE(PG8_SA(0, 1), cA + hstep, voffA);
        if (wr == 1) PG8_BAR;
        PG8_WAIT_V(4); PG8_BAR;
        PG8_STAGE(PG8_SB(1, 0), cB + kstep, voffB); PG8_STAGE(PG8_SA(1, 0), cA + kstep, voffA); PG8_STAGE(PG8_SB(1, 1), cB + hstep + kstep, voffB);
        PG8_WAIT_V(6); PG8_BAR;
    }
    for (;;) {
        const bool has_next = S.next(ui + 1, nxt);
        const char* nA = has_next ? (const char*)g.A + (size_t)nxt.pm * tstep : cA; const char* nB = has_next ? (const char*)g.Bt + (size_t)nxt.pn * tstep : cB;
        for (int t = 0; t < nt; t += 2) {
            const bool last = (t == nt - 2);
            const char* a1 = cA + (size_t)(t + 1) * kstep;
            const char* a2 = last ? nA : cA + (size_t)(t + 2) * kstep; const char* b2 = last ? nB : cB + (size_t)(t + 2) * kstep;
            const char* a3 = a2 + kstep; const char* b3 = b2 + kstep;
            if (last && has_next) S.a_ready(nxt);
            if constexpr (SP2) {
            PG8_LDB(B0, 0, 0); PG8_LDB(B1, 0, 1); PG8_SCHED; PG8_LDA(At, 0, 0); PG8_STAGE(PG8_SA(1, 1), a1 + hstep, voffA);
            PG8_WAIT_V(8); PG8_WAIT_L(0); PG8_BAR; PG8_MMA(0, 0, At, B0); PG8_MMA(0, 1, At, B1); PG8_BAR; PG8_SCHED;
            PG8_LDA(At, 0, 1); PG8_STAGE(PG8_SB(0, 0), b2, voffB); PG8_STAGE(PG8_SB(0, 1), b2 + hstep, voffB); PG8_STAGE(PG8_SA(0, 0), a2, voffA);
            PG8_WAIT_V(8); PG8_WAIT_L(0); PG8_BAR; PG8_MMA(1, 0, At, B0); PG8_MMA(1, 1, At, B1); PG8_BAR; PG8_SCHED;
            PG8_LDB(B0, 1, 0); PG8_LDB(B1, 1, 1); PG8_SCHED; PG8_LDA(At, 1, 0); PG8_STAGE(PG8_SA(0, 1), a2 + hstep, voffA);
            PG8_WAIT_V(8); PG8_WAIT_L(0); PG8_BAR; PG8_MMA(0, 0, At, B0); PG8_MMA(0, 1, At, B1); PG8_BAR; PG8_SCHED;
            PG8_LDA(At, 1, 1); PG8_STAGE(PG8_SB(1, 0), b3, voffB); PG8_STAGE(PG8_SB(1, 1), b3 + hstep, voffB); PG8_STAGE(PG8_SA(1, 0), a3, voffA);
            PG8_WAIT_V(8); PG8_WAIT_L(0); PG8_BAR; PG8_MMA(1, 0, At, B0); PG8_MMA(1, 1, At, B1); PG8_BAR; PG8_SCHED;
            } else {
            PG8_LDB(B0, 0, 0); PG8_SCHED; PG8_LDA(At, 0, 0); PG8_STAGE(PG8_SA(1, 1), a1 + hstep, voffA);
            PG8_WAIT_L(8); PG8_BAR; PG8_WAIT_L(0); PG8_MMA(0, 0, At, B0); PG8_BAR; PG8_SCHED;
            PG8_LDB(B1, 0, 1); PG8_STAGE(PG8_SB(0, 0), b2, voffB);
            PG8_BAR; PG8_WAIT_L(0); PG8_MMA(0, 1, At, B1); PG8_BAR;
            PG8_LDA(At, 0, 1); PG8_STAGE(PG8_SA(0, 0), a2, voffA);
            PG8_BAR; PG8_WAIT_L(0); PG8_MMA(1, 0, At, B0); PG8_BAR; PG8_SCHED;
            PG8_STAGE(PG8_SB(0, 1), b2 + hstep, voffB);
            PG8_WAIT_V(6); PG8_BAR; PG8_MMA(1, 1, At, B1); PG8_BAR;
            PG8_LDB(B0, 1, 0); PG8_SCHED; PG8_LDA(At, 1, 0); PG8_STAGE(PG8_SA(0, 1), a2 + hstep, voffA);
            PG8_WAIT_L(8); PG8_BAR; PG8_WAIT_L(0); PG8_MMA(0, 0, At, B0); PG8_BAR; PG8_SCHED;
            PG8_LDB(B1, 1, 1); PG8_STAGE(PG8_SB(1, 0), b3, voffB);
            PG8_BAR; PG8_WAIT_L(0); PG8_MMA(0, 1, At, B1); PG8_BAR;
            PG8_LDA(At, 1, 1); PG8_STAGE(PG8_SA(1, 0), a3, voffA);
            PG8_BAR; PG8_WAIT_L(0); PG8_MMA(1, 0, At, B0); PG8_BAR; PG8_SCHED;
            PG8_STAGE(PG8_SB(1, 1), b3 + hstep, voffB);
            PG8_WAIT_V(6); PG8_BAR; PG8_MMA(1, 1, At, B1); PG8_BAR;
            }
        }
        if constexpr (ALIGN_EPI) { if (wr == 0) PG8_BAR; }
        if constexpr (!Epi::AFTER_DRAIN) { E(acc, cur, wr, wc, fr, fq); S.done(cur); }
        if (!has_next) break;
#pragma unroll
        for (int a = 0; a < 2; ++a)
#pragma unroll
            for (int b = 0; b < 2; ++b)
#pragma unroll
                for (int m = 0; m < 4; ++m)
#pragma unroll
                    for (int n = 0; n < 2; ++n) acc[a][b][m][n] = (f32x4){0.f, 0.f, 0.f, 0.f};
        cur = nxt; cA = nA; cB = nB; ++ui;
        if constexpr (ALIGN_EPI) { if (wr == 1) PG8_BAR; }
    }
    PG8_WAIT_V(0);
    if constexpr (!ALIGN_EPI) { if (wr == 0) PG8_BAR; }
    PG8_BAR;
    if constexpr (Epi::AFTER_DRAIN) { E.fused(acc, cur, wr, wc, fr, fq, lds, wid, lane); S.done(cur); }
#undef PG8_SA
#undef PG8_SB
#undef PG8_STAGE
#undef PG8_LDA
#undef PG8_LDB
#undef PG8_MMA
#undef PG8_WAIT_V
#undef PG8_WAIT_L
#undef PG8_BAR
#undef PG8_SCHED
}
}
#include <hip/hip_bf16.h>
#include <cmath>
namespace attn_body {
using bf16=__hip_bfloat16;
using bf16x8=__attribute__((ext_vector_type(8)))short;
using s16x4=__attribute__((ext_vector_type(4)))short;
using f32x16=__attribute__((ext_vector_type(16)))float;
using u32x4=__attribute__((ext_vector_type(4)))unsigned;
constexpr int BATCH=4,NHEAD=16,SEQ=8192,D=64,DM=1024;
constexpr int NW=8,QBLK=32,QB=QBLK*NW,KVBLK=64,NQB=SEQ/QB;
constexpr int ATTN_PITCH=DM, ATTN_UNIT_ROWS=QB;
__device__ __forceinline__ int crow(int r,int hi){return (r&3)+8*(r>>2)+4*hi;}
#define SBAR() __builtin_amdgcn_sched_barrier(0)
__device__ __forceinline__ void cmask(f32x16&p0,f32x16&p1,int jb,int qrel,int hi){
  const float NEG=-INFINITY; int kb=64*jb+4*hi;
  #pragma unroll
  for(int r=0;r<16;++r){int kv=kb+(r&3)+8*(r>>2); if(kv>qrel)p0[r]=NEG; if(kv+32>qrel)p1[r]=NEG;}
}

constexpr int NSLOT=3, SLOTB=8192;
constexpr int LDS_K=0, LDS_V=NSLOT*SLOTB, LDS_WS=2*NSLOT*SLOTB, LDS_OST=LDS_WS+NW*64*4, LDS_BYTES=LDS_OST+NW*4096;
constexpr float C2=0.125f*1.4426950408889634f;
__device__ __forceinline__ void glds16(const void*gsrc,unsigned lds_dst){unsigned keep;
  asm volatile("s_mov_b32 %0, m0\n\ts_mov_b32 m0, %2\n\ts_nop 0\n\tglobal_load_lds_dwordx4 %1, off\n\ts_mov_b32 m0, %0":"=&s"(keep):"v"(gsrc),"s"(lds_dst):"memory");}
__device__ __forceinline__ float max3f(float a,float b,float c){float r;asm("v_max3_f32 %0, %1, %2, %3":"=v"(r):"v"(a),"v"(b),"v"(c));return r;}
__device__ __forceinline__ float max2f(float a,float b){float r;asm("v_max_f32_e32 %0, %1, %2":"=v"(r):"v"(a),"v"(b));return r;}
__device__ __forceinline__ float fadd_s(float a,float b){float r;asm("v_add_f32_e32 %0, %1, %2":"=v"(r):"v"(a),"v"(b));return r;}
__device__ __forceinline__ float fsub_s(float a,float b){float r;asm("v_sub_f32_e32 %0, %1, %2":"=v"(r):"v"(a),"v"(b));return r;}
typedef float f32x2_t __attribute__((ext_vector_type(2))); typedef __bf16 bf16x2_t __attribute__((ext_vector_type(2)));
__device__ __forceinline__ unsigned cvtpk_s(float lo,float hi){f32x2_t v={lo,hi};bf16x2_t b=__builtin_convertvector(v,bf16x2_t);return __builtin_bit_cast(unsigned,b);}
#define WAIT_BAR(N) asm volatile("s_waitcnt vmcnt(" #N ") lgkmcnt(0)\n\ts_barrier":::"memory")

__device__ __forceinline__ void qkt(f32x16&p0,f32x16&p1,const char*Kslot,const bf16x8*qr,const f32x16&negm,int r32,int hi){
  const char*kb=Kslot+hi*1024+r32*16;
  #pragma unroll
  for(int d0=0;d0<4;++d0){
    const bf16x8 b0=*reinterpret_cast<const bf16x8*>(kb+d0*2048);
    const bf16x8 b1=*reinterpret_cast<const bf16x8*>(kb+d0*2048+512);
    if(d0==0){p0=__builtin_amdgcn_mfma_f32_32x32x16_bf16(b0,qr[0],negm,0,0,0);p1=__builtin_amdgcn_mfma_f32_32x32x16_bf16(b1,qr[0],negm,0,0,0);}
    else{p0=__builtin_amdgcn_mfma_f32_32x32x16_bf16(b0,qr[d0],p0,0,0,0);p1=__builtin_amdgcn_mfma_f32_32x32x16_bf16(b1,qr[d0],p1,0,0,0);}}
}
typedef __attribute__((address_space(3))) const char* lds_cptr;
typedef short v4i16_t __attribute__((ext_vector_type(4)));
__device__ __forceinline__ void kload8(bf16x8*kf,lds_cptr kp){
  kf[0]=*(const __attribute__((address_space(3))) bf16x8*)(kp);      kf[1]=*(const __attribute__((address_space(3))) bf16x8*)(kp+512);
  kf[2]=*(const __attribute__((address_space(3))) bf16x8*)(kp+2048); kf[3]=*(const __attribute__((address_space(3))) bf16x8*)(kp+2560);
  kf[4]=*(const __attribute__((address_space(3))) bf16x8*)(kp+4096); kf[5]=*(const __attribute__((address_space(3))) bf16x8*)(kp+4608);
  kf[6]=*(const __attribute__((address_space(3))) bf16x8*)(kp+6144); kf[7]=*(const __attribute__((address_space(3))) bf16x8*)(kp+6656);
}
__device__ __forceinline__ void kload2(bf16x8*kf,lds_cptr kp,int j){ kf[2*j]=*(const __attribute__((address_space(3))) bf16x8*)(kp+j*2048); kf[2*j+1]=*(const __attribute__((address_space(3))) bf16x8*)(kp+j*2048+512); }
__device__ __forceinline__ s16x4 vtr(lds_cptr p){ return __builtin_bit_cast(s16x4,__builtin_amdgcn_ds_read_tr16_b64_v4i16((__attribute__((address_space(3))) v4i16_t*)p)); }
__device__ __forceinline__ float rowmax(const f32x16&p0,const f32x16&p1){
  float a=max3f(p0[0],p0[1],p1[0]),b=max3f(p0[2],p0[3],p1[1]);a=max3f(a,p1[2],p1[3]);
  #pragma unroll
  for(int r=4;r<16;r+=4){a=max3f(a,p0[r],p0[r+1]);b=max3f(b,p0[r+2],p0[r+3]);a=max3f(a,p1[r],p1[r+1]);b=max3f(b,p1[r+2],p1[r+3]);}
  const float m=max2f(a,b);
  auto rr=__builtin_amdgcn_permlane32_swap(__float_as_uint(m),__float_as_uint(m),false,false);
  return max2f(__uint_as_float(rr[0]),__uint_as_float(rr[1]));
}
__device__ __forceinline__ void pv(f32x16*o,int vb,bf16x8 pa0,bf16x8 pa1,bf16x8 pa2,bf16x8 pa3){
  #pragma unroll
  for(int d0=0;d0<2;++d0){s16x4 lo[4],hi[4];
    #pragma unroll
    for(int ks=0;ks<4;++ks){
      asm volatile("ds_read_b64_tr_b16 %0,%1 offset:%c2":"=&v"(lo[ks]):"v"(vb),"i"(d0*4096+ks*1024):"memory");
      asm volatile("ds_read_b64_tr_b16 %0,%1 offset:%c2":"=&v"(hi[ks]):"v"(vb),"i"(d0*4096+ks*1024+512):"memory");}
    asm volatile("s_waitcnt lgkmcnt(0)":::"memory");SBAR();
    #define PK(k) (bf16x8){lo[k][0],lo[k][1],lo[k][2],lo[k][3],hi[k][0],hi[k][1],hi[k][2],hi[k][3]}
    o[d0]=__builtin_amdgcn_mfma_f32_32x32x16_bf16(pa0,PK(0),o[d0],0,0,0);
    o[d0]=__builtin_amdgcn_mfma_f32_32x32x16_bf16(pa1,PK(1),o[d0],0,0,0);
    o[d0]=__builtin_amdgcn_mfma_f32_32x32x16_bf16(pa2,PK(2),o[d0],0,0,0);
    o[d0]=__builtin_amdgcn_mfma_f32_32x32x16_bf16(pa3,PK(3),o[d0],0,0,0);
    #undef PK
  }
}

#ifndef ATTN_STORE16
#define ATTN_STORE16(p,v) (*(u32x4*)(p)=(v))
#endif
template<int THRL> __device__ __forceinline__ void attn_unit(int b,int qcol,int kcol,int vcol,int ocol,int qb,const bf16*Q,const bf16*__restrict__ K,const bf16*__restrict__ V,bf16*O,char*shm){
  const int tid=threadIdx.x,lane=tid&63,r32=lane&31,hi=lane>>5; const int wid=__builtin_amdgcn_readfirstlane(tid>>6);
  const long rowbase=(long)b*SEQ; const int q0=qb*QB;
  const bf16*Qw=Q+(rowbase+q0+wid*QBLK)*DM+qcol;
  const bf16*Kh=K+rowbase*DM+kcol,*Vh=V+rowbase*DM+vcol;
  const unsigned lds0=(unsigned)(uintptr_t)shm;
  float*wsf=(float*)(shm+LDS_WS)+wid*64;
  const bf16*ksrc=Kh+(long)lane*DM+wid*8;
  const bf16*vsrc=Vh+(long)(16*(wid&3)+(lane>>2))*DM+(wid>>2)*32+(lane&3)*8;
  const unsigned kdst=lds0+LDS_K+wid*1024, vdst=lds0+LDS_V+wid*1024;
  #define DMA_K(t,slot) glds16(ksrc+(long)(t)*KVBLK*DM,(unsigned)__builtin_amdgcn_readfirstlane(kdst+(slot)))
  #define DMA_V(t,slot) glds16(vsrc+(long)(t)*KVBLK*DM,(unsigned)__builtin_amdgcn_readfirstlane(vdst+(slot)))
  const int vb0=(int)(lds0+LDS_V)+((lane>>4)&1)*32+(lane&3)*8+(4*hi+((lane&15)>>2))*64;
  const char*Kbase=shm+LDS_K; bf16x8 kf[8];
  const lds_cptr shm3=(lds_cptr)shm; const lds_cptr kp0=shm3+LDS_K+hi*1024+r32*16; const lds_cptr vp0=shm3+LDS_V+((lane>>4)&1)*32+(lane&3)*8+(4*hi+((lane&15)>>2))*64;
  const int NT=(q0+QB)/KVBLK;
  DMA_K(0,0);DMA_V(0,0);DMA_K(1,SLOTB);
  bf16x8 qr[4];
  #pragma unroll
  for(int d0=0;d0<4;++d0)qr[d0]=*reinterpret_cast<const bf16x8*>(&Qw[(long)r32*DM+d0*16+hi*8]);
  float mhat=0.f,l_reg=0.f;f32x16 o[2];o[0]=f32x16{};o[1]=f32x16{};f32x16 negm=f32x16{};asm volatile("":"+v"(negm));
  const int qrel=wid*QBLK+r32;
  #define CMASK(P0,P1,t) do{int jb_=(t)-(NT-4); if(jb_>=0)cmask(P0,P1,jb_,qrel,hi);}while(0)
  bool resc=false;
  #define START(P0,P1) do{ const float rm=rowmax(P0,P1); resc=false; \
    { const float dl=rm; mhat=fadd_s(mhat,dl); \
      _Pragma("unroll") for(int r=0;r<16;++r){P0[r]=fsub_s(P0[r],dl);P1[r]=fsub_s(P1[r],dl);} \
      _Pragma("unroll") for(int r=0;r<16;++r)negm[r]=-mhat; asm volatile("":"+v"(negm)); } \
    _Pragma("unroll") for(int r=0;r<16;++r)P0[r]=__builtin_amdgcn_exp2f(P0[r]); }while(0)
  #define RESC() do{ if(resc){ asm volatile("s_waitcnt lgkmcnt(0)":::"memory"); \
      _Pragma("unroll") for(int d_=0;d_<2;++d_) _Pragma("unroll") for(int r=0;r<16;++r)o[d_][r]*=wsf[crow(r,hi)]; } }while(0)
  f32x16 pA0,pA1,pB0,pB1;
  int sl_prev=0,sl_cur=0,sl_next=SLOTB;
  #define ROT() do{sl_prev=sl_cur;sl_cur=sl_next;sl_next=(sl_next==(NSLOT-1)*SLOTB)?0:sl_next+SLOTB;}while(0)
  DMA_K(2,2*SLOTB);
  WAIT_BAR(3);
  qkt(pA0,pA1,Kbase,qr,negm,r32,hi);asm volatile("s_nop 15\n\ts_nop 7":"+v"(pA0),"+v"(pA1));CMASK(pA0,pA1,0);
  START(pA0,pA1);
  _Pragma("unroll") for(int r=0;r<16;++r)pA1[r]=__builtin_amdgcn_exp2f(pA1[r]);
  WAIT_BAR(0);
  DMA_K(3,0);DMA_V(1,SLOTB);
  ROT();
  kload8(kf,kp0+sl_cur);
  WAIT_BAR(2);
  s16x4 vlo[8],vhi[8]; u32x4 pw0,pw1,pw2,pw3;
  #define PKW(P,B) cvtpk_s(P[B],P[B+1])
  #define PAF(k) __builtin_bit_cast(bf16x8,pw##k)
  #define VFR(i) (bf16x8){vlo[i][0],vlo[i][1],vlo[i][2],vlo[i][3],vhi[i][0],vhi[i][1],vhi[i][2],vhi[i][3]}
  #define PIN(x) asm volatile("":"+v"(x))
  #define MX3(a,b,c) __builtin_fmaxf(__builtin_fmaxf((a),(b)),(c))
  #define GAPA(MF,A0,A1,A2,A3,W0,W1,PW) do{ MF; sacc+=A0; sacc+=A1; sacc+=A2; sacc+=A3; PIN(sacc); W0; W1; PIN(PW); SBAR(); }while(0)
  #define EX(v) __builtin_amdgcn_exp2f(v)
  #define GAPB(MF,X,B) do{ MF; X[B]=EX(X[B]); X[B+1]=EX(X[B+1]); X[B+2]=EX(X[B+2]); X[B+3]=EX(X[B+3]); PIN(X); SBAR(); }while(0)
  #define VRD(i) do{ vlo[i]=vtr(vp_+(((i)>>2)*4096+((i)&3)*1024)); vhi[i]=vtr(vp_+(((i)>>2)*4096+((i)&3)*1024+512)); }while(0)
  #define KRD(G,j) do{ if(G){ kload2(kf,kp0+sl_next,j); SBAR(); } }while(0)
  #define STEP(C0,C1,P0,P1,t,GK,GV,GL) do{ SBAR(); \
    const lds_cptr vp_=vp0+sl_prev; \
    VRD(0); SBAR(); float sacc=(P0[0]+P0[1]); \
    GAPA(C0=__builtin_amdgcn_mfma_f32_32x32x16_bf16(kf[0],qr[0],negm,0,0,0), P0[2],P0[3],P0[4],P0[5],     pw0[0]=PKW(P0,0), pw0[1]=PKW(P0,2), pw0); \
    VRD(4); SBAR(); GAPA(C1=__builtin_amdgcn_mfma_f32_32x32x16_bf16(kf[1],qr[0],negm,0,0,0), P0[6],P0[7],P0[8],P0[9],     pw0[2]=PKW(P0,4), pw0[3]=PKW(P0,6), pw0); \
    VRD(1); SBAR(); GAPA(C0=__builtin_amdgcn_mfma_f32_32x32x16_bf16(kf[2],qr[1],C0,0,0,0),   P0[10],P0[11],P0[12],P0[13], pw1[0]=PKW(P0,8), pw1[1]=PKW(P0,10), pw1); \
    VRD(5); SBAR(); GAPA(C1=__builtin_amdgcn_mfma_f32_32x32x16_bf16(kf[3],qr[1],C1,0,0,0),   P0[14],P0[15],P1[0],P1[1],   pw1[2]=PKW(P0,12),pw1[3]=PKW(P0,14), pw1); \
    VRD(2); SBAR(); GAPA(C0=__builtin_amdgcn_mfma_f32_32x32x16_bf16(kf[4],qr[2],C0,0,0,0),   P1[2],P1[3],P1[4],P1[5],     pw2[0]=PKW(P1,0), pw2[1]=PKW(P1,2), pw2); \
    VRD(6); SBAR(); GAPA(C1=__builtin_amdgcn_mfma_f32_32x32x16_bf16(kf[5],qr[2],C1,0,0,0),   P1[6],P1[7],P1[8],P1[9],     pw2[2]=PKW(P1,4), pw2[3]=PKW(P1,6), pw2); \
    VRD(3); SBAR(); GAPA(C0=__builtin_amdgcn_mfma_f32_32x32x16_bf16(kf[6],qr[3],C0,0,0,0),   P1[10],P1[11],P1[12],P1[13], pw3[0]=PKW(P1,8), pw3[1]=PKW(P1,10), pw3); \
    VRD(7); SBAR(); GAPA(C1=__builtin_amdgcn_mfma_f32_32x32x16_bf16(kf[7],qr[3],C1,0,0,0),   P1[14],P1[15],0.f,0.f,       pw3[2]=PKW(P1,12),pw3[3]=PKW(P1,14), pw3); \
    l_reg+=sacc; \
    if(GK){DMA_K((t)+3,sl_cur);} if(GV){DMA_V((t)+1,sl_next);} \
    CMASK(C0,C1,t); \
    { float a=MX3(C0[0],C0[1],C1[0]),b=MX3(C0[2],C0[3],C1[1]); a=MX3(a,C1[2],C1[3]); \
      _Pragma("unroll") for(int r=4;r<16;r+=4){a=MX3(a,C0[r],C0[r+1]);b=MX3(b,C0[r+2],C0[r+3]);a=MX3(a,C1[r],C1[r+1]);b=MX3(b,C1[r+2],C1[r+3]);} \
      float rm=__builtin_fmaxf(a,b); { auto rr=__builtin_amdgcn_permlane32_swap(__float_as_uint(rm),__float_as_uint(rm),false,false); rm=__builtin_fmaxf(__uint_as_float(rr[0]),__uint_as_float(rr[1])); } \
      resc=false; \
      if(__builtin_expect(__any(rm>(float)THRL),0)){ const float dl=__builtin_fmaxf(rm,0.f); mhat+=dl; \
        _Pragma("unroll") for(int r=0;r<16;++r){C0[r]-=dl;C1[r]-=dl;} \
        _Pragma("unroll") for(int r=0;r<16;++r)negm[r]=-mhat; asm volatile("":"+v"(negm)); \
        const float f=__builtin_amdgcn_exp2f(-dl); l_reg*=f; if(hi==0)wsf[r32]=f; resc=true; } } \
    SBAR(); \
    GAPB(o[0]=__builtin_amdgcn_mfma_f32_32x32x16_bf16(PAF(0),VFR(0),o[0],0,0,0), C0,0); \
    GAPB(o[1]=__builtin_amdgcn_mfma_f32_32x32x16_bf16(PAF(0),VFR(4),o[1],0,0,0), C0,4); \
    KRD(GL,0); GAPB(o[0]=__builtin_amdgcn_mfma_f32_32x32x16_bf16(PAF(1),VFR(1),o[0],0,0,0), C0,8); \
    KRD(GL,1); GAPB(o[1]=__builtin_amdgcn_mfma_f32_32x32x16_bf16(PAF(1),VFR(5),o[1],0,0,0), C0,12); \
    KRD(GL,2); GAPB(o[0]=__builtin_amdgcn_mfma_f32_32x32x16_bf16(PAF(2),VFR(2),o[0],0,0,0), C1,0); \
    KRD(GL,3); GAPB(o[1]=__builtin_amdgcn_mfma_f32_32x32x16_bf16(PAF(2),VFR(6),o[1],0,0,0), C1,4); \
    GAPB(o[0]=__builtin_amdgcn_mfma_f32_32x32x16_bf16(PAF(3),VFR(3),o[0],0,0,0), C1,8); \
    GAPB(o[1]=__builtin_amdgcn_mfma_f32_32x32x16_bf16(PAF(3),VFR(7),o[1],0,0,0), C1,12); \
    }while(0)
  int t=1;
  #undef CMASK
  #define CMASK(P0,P1,t) do{}while(0)
  for(;t+5<NT;t+=2){
    STEP(pB0,pB1,pA0,pA1,t,true,true,true);     WAIT_BAR(2); RESC(); ROT();
    STEP(pA0,pA1,pB0,pB1,t+1,true,true,true);   WAIT_BAR(2); RESC(); ROT();
  }
  #undef CMASK
  #define CMASK(P0,P1,t) do{int jb_=(t)-(NT-4); if(jb_>=0)cmask(P0,P1,jb_,qrel,hi);}while(0)
  #define ENDW(tt) do{ if((tt)+3<NT){WAIT_BAR(2);} else if((tt)+2<NT){WAIT_BAR(1);} else {WAIT_BAR(0);} }while(0)
  for(;t+1<NT;t+=2){
    STEP(pB0,pB1,pA0,pA1,t,(t+3<NT),(t+1<NT),(t+1<NT));       ENDW(t);   RESC(); ROT();
    STEP(pA0,pA1,pB0,pB1,t+1,(t+4<NT),(t+2<NT),(t+2<NT));     ENDW(t+1); RESC(); ROT();
  }
  STEP(pB0,pB1,pA0,pA1,NT-1,false,false,false); RESC();
  { float sacc=pB0[0]+pB0[1]; _Pragma("unroll") for(int r=2;r<16;++r)sacc+=pB0[r]; _Pragma("unroll") for(int r=0;r<16;++r)sacc+=pB1[r]; l_reg+=sacc;
    pw0=(u32x4){PKW(pB0,0),PKW(pB0,2),PKW(pB0,4),PKW(pB0,6)};pw1=(u32x4){PKW(pB0,8),PKW(pB0,10),PKW(pB0,12),PKW(pB0,14)};pw2=(u32x4){PKW(pB1,0),PKW(pB1,2),PKW(pB1,4),PKW(pB1,6)};pw3=(u32x4){PKW(pB1,8),PKW(pB1,10),PKW(pB1,12),PKW(pB1,14)};
    SBAR(); pv(o,vb0+sl_cur,PAF(0),PAF(1),PAF(2),PAF(3)); }
  #undef PKW
  #undef PAF
  #undef VFR
  #undef PIN
  #undef MX3
  #undef GAPA
  #undef GAPB
  #undef EX
  #undef VRD
  #undef KRD
  #undef STEP
  #undef ENDW
  {auto rr=__builtin_amdgcn_permlane32_swap(__float_as_uint(l_reg),__float_as_uint(l_reg),false,false);l_reg=__uint_as_float(rr[0])+__uint_as_float(rr[1]);}
  if(hi==0)wsf[32+r32]=l_reg;asm volatile("s_waitcnt lgkmcnt(0)":::"memory");
  float rli[16];
  #pragma unroll
  for(int r=0;r<16;++r)rli[r]=__builtin_amdgcn_rcpf(wsf[32+crow(r,hi)]);
  bf16*Ow=O+(rowbase+q0+wid*QBLK)*DM+ocol;
  { bf16*stg=(bf16*)(shm+LDS_OST)+wid*2048;
    #pragma unroll
    for(int r=0;r<16;++r){const int orow=crow(r,hi);
      #pragma unroll
      for(int d0=0;d0<2;++d0)stg[orow*64+d0*32+r32]=__float2bfloat16(o[d0][r]*rli[r]);}
    asm volatile("s_waitcnt lgkmcnt(0)":::"memory");
    #pragma unroll
    for(int i=0;i<4;++i){const int row=i*8+(lane>>3),ch=lane&7; const u32x4 v=*(const u32x4*)(stg+row*64+ch*8); ATTN_STORE16(Ow+(long)row*DM+ch*8,v);} }
  asm volatile("s_waitcnt lgkmcnt(0)\n\ts_barrier":::"memory");
  #undef DMA_K
  #undef DMA_V
  #undef CMASK
  #undef START
  #undef RESC
  #undef ROT
}
constexpr int ATTN_LDS_BYTES=LDS_BYTES;
__device__ __forceinline__ void qkt0(f32x16&p0,f32x16&p1,const char*Kslot,const bf16x8*qr,int r32,int hi){
  const char*kb=Kslot+hi*1024+r32*16; const f32x16 z=f32x16{};
  #pragma unroll
  for(int d0=0;d0<4;++d0){
    const bf16x8 b0=*reinterpret_cast<const bf16x8*>(kb+d0*2048);
    const bf16x8 b1=*reinterpret_cast<const bf16x8*>(kb+d0*2048+512);
    if(d0==0){p0=__builtin_amdgcn_mfma_f32_32x32x16_bf16(b0,qr[0],z,0,0,0);p1=__builtin_amdgcn_mfma_f32_32x32x16_bf16(b1,qr[0],z,0,0,0);}
    else{p0=__builtin_amdgcn_mfma_f32_32x32x16_bf16(b0,qr[d0],p0,0,0,0);p1=__builtin_amdgcn_mfma_f32_32x32x16_bf16(b1,qr[d0],p1,0,0,0);}}
}
__device__ __forceinline__ const char* mk_ws_ptr();
__device__ __forceinline__ const float* mk_in_ptr(int k);
constexpr int U2_VS=4;
constexpr int U2_K=0, U2_VA=NSLOT*SLOTB, U2_VB=U2_VA+U2_VS*SLOTB, U2_WS=U2_VB+U2_VS*SLOTB, U2_OST=U2_WS+NW*64*4, U2_BYTES=U2_OST+NW*4096;
template<int THRL,int MODE> __device__ __forceinline__ void attn_unit2(int b,int qcol,int kcol,int vcol,int ocol,int qb,size_t q_off,size_t k_off,size_t v_off,size_t o_off,size_t o0_off,int subg_idx,char*shm,float lam,
    bf16x8 (&qr)[4],bool pre,bool hasn,int nb,int nqcol,int nkcol,int nvcol,int nqb){
  const bf16*Q,*K,*V; { const char*w_=mk_ws_ptr(); Q=(const bf16*)(w_+q_off); K=(const bf16*)(w_+k_off); V=(const bf16*)(w_+v_off); }
  int tid_=threadIdx.x; asm volatile("":"+v"(tid_));
  const int tid=tid_,lane=tid&63,r32=lane&31,hi=lane>>5; const int wid=__builtin_amdgcn_readfirstlane(tid>>6);
  const long rowbase=(long)b*SEQ; const int q0=qb*QB;
  const bf16*Qw=Q+(rowbase+q0+wid*QBLK)*DM+qcol;
  const bf16*Kh=K+rowbase*DM+kcol,*Vh=V+rowbase*DM+vcol;
  const unsigned lds0=(unsigned)(uintptr_t)shm;
  float*wsf=(float*)(shm+U2_WS)+wid*64;
  const bf16*ksrc=Kh+(long)lane*DM+wid*8;
  const bf16*vsrc=Vh+(long)(16*(wid&3)+(lane>>2))*DM+(wid>>2)*32+(lane&3)*8;
  const unsigned kdst=lds0+U2_K+wid*1024, vdstA=lds0+U2_VA+wid*1024, vdstB=lds0+U2_VB+wid*1024;
  #define RFL(x) ((unsigned)__builtin_amdgcn_readfirstlane(x))
  #define DMAK(n,slot) glds16(ksrc+(long)(n)*KVBLK*DM,RFL(kdst+(slot)))
  #define DMAV(n,slot) do{ glds16(vsrc+(long)(n)*KVBLK*DM,RFL(vdstA+(slot))); glds16(vsrc+(long)(n)*KVBLK*DM+64,RFL(vdstB+(slot))); }while(0)
  const int vbo=((lane>>4)&1)*32+(lane&3)*8+(4*hi+((lane&15)>>2))*64;
  const char*Kbase=shm+U2_K;
  const int NT=(q0+QB)/KVBLK;
  if(!pre){
    #pragma unroll
    for(int d0=0;d0<4;++d0)qr[d0]=*reinterpret_cast<const bf16x8*>(&Qw[(long)r32*DM+d0*16+hi*8]);
    asm volatile("":::"memory");
    DMAK(0,0); DMAV(0,0); DMAK(1,SLOTB); DMAV(1,SLOTB); DMAK(2,2*SLOTB);
  }
  float mhat=0.f,l_reg=0.f; f32x16 o[4]; o[0]=f32x16{};o[1]=f32x16{};o[2]=f32x16{};o[3]=f32x16{};
  const int qrel=wid*QBLK+r32;
  u32x4 pw[4];
  u32x4 g0_[2][4];
  const lds_cptr shm3=(lds_cptr)shm; const lds_cptr vpA0=shm3+U2_VA+vbo, vpB0=shm3+U2_VB+vbo, kp0=shm3+U2_K+hi*1024+r32*16;
  #define PKV(L,H) (bf16x8){L[0],L[1],L[2],L[3],H[0],H[1],H[2],H[3]}
  #define PIN(x) asm volatile("":"+v"(x))
  #define KLD(kp,q) (*(const __attribute__((address_space(3))) bf16x8*)((kp)+((q)>>1)*2048+((q)&1)*512))
  #define STEP2(PC0,PC1,PN0,PN1,t,FIRST,HASPV,HASQK,PREF) do{ \
    if((t)+2<NT){WAIT_BAR(3);}else if((t)+1<NT){WAIT_BAR(2);}else{WAIT_BAR(0);}     \
    if(PREF&&MODE==1){ const bf16*o0w_=(const bf16*)(mk_ws_ptr()+o0_off)+((long)b*SEQ+(long)qb*QB+wid*QBLK)*DM+ocol; \
      _Pragma("unroll") for(int h2=0;h2<2;++h2) _Pragma("unroll") for(int i=0;i<4;++i){const int row=i*8+(lane>>3),ch=lane&7; g0_[h2][i]=*(const u32x4*)(o0w_+(long)row*DM+h2*64+ch*8);} } \
    if(PREF){ if(hasn){ const char*wn_=mk_ws_ptr(); const long nrb_=(long)nb*SEQ; \
        const bf16*nks_=(const bf16*)(wn_+k_off)+nrb_*DM+nkcol+(long)lane*DM+wid*8; \
        const bf16*nvs_=(const bf16*)(wn_+v_off)+nrb_*DM+nvcol+(long)(16*(wid&3)+(lane>>2))*DM+(wid>>2)*32+(lane&3)*8; \
        const bf16*nqw_=(const bf16*)(wn_+q_off)+(nrb_+(long)nqb*QB+wid*QBLK)*DM+nqcol; \
        glds16(nks_,RFL(kdst)); glds16(nvs_,RFL(vdstA)); glds16(nvs_+64,RFL(vdstB)); \
        glds16(nks_+(long)KVBLK*DM,RFL(kdst+SLOTB)); glds16(nvs_+(long)KVBLK*DM,RFL(vdstA+SLOTB)); glds16(nvs_+(long)KVBLK*DM+64,RFL(vdstB+SLOTB)); \
        glds16(nks_+2L*KVBLK*DM,RFL(kdst+2*SLOTB)); \
        _Pragma("unroll") for(int d0=0;d0<4;++d0)qr[d0]=*reinterpret_cast<const bf16x8*>(&nqw_[(long)r32*DM+d0*16+hi*8]); } } \
    const lds_cptr vpA=vpA0+(((t)+3)&3)*SLOTB, vpB=vpB0+(((t)+3)&3)*SLOTB, kp=kp0+(((t)+1)%3)*SLOTB; \
    s16x4 fl[4],fh[4]; bf16x8 kf[2]; float sacc=0.f; \
    SBAR(); \
    if(HASPV){ fl[0]=vtr(vpA); fh[0]=vtr(vpA+512); fl[1]=vtr(vpA+4096); fh[1]=vtr(vpA+4096+512); } \
    if(HASQK){ kf[0]=KLD(kp,0); } \
    SBAR(); \
      \
    if((t)+3<NT)DMAK((t)+3,((t)%3)*SLOTB); \
    if((t)+2<NT)DMAV((t)+2,(((t)+2)&3)*SLOTB); \
      \
    if(HASPV){ _Pragma("unroll") for(int i=0;i<4;++i){ \
        { const int g=i+2, jj=g&3, ks=g>>2; const lds_cptr vp=((jj>>1)?vpB:vpA)+((jj&1)*4096+ks*1024); fl[g&3]=vtr(vp); fh[g&3]=vtr(vp+512); } \
        o[i]=__builtin_amdgcn_mfma_f32_32x32x16_bf16(__builtin_bit_cast(bf16x8,pw[0]),PKV(fl[i],fh[i]),o[i],0,0,0); SBAR(); } } \
    float rm; \
    { float a=__builtin_fmaxf(__builtin_fmaxf(PC0[0],PC0[1]),PC1[0]),bb=__builtin_fmaxf(__builtin_fmaxf(PC0[2],PC0[3]),PC1[1]); a=__builtin_fmaxf(__builtin_fmaxf(a,PC1[2]),PC1[3]); \
      _Pragma("unroll") for(int r=4;r<16;r+=4){a=__builtin_fmaxf(__builtin_fmaxf(a,PC0[r]),PC0[r+1]);bb=__builtin_fmaxf(__builtin_fmaxf(bb,PC0[r+2]),PC0[r+3]);a=__builtin_fmaxf(__builtin_fmaxf(a,PC1[r]),PC1[r+1]);bb=__builtin_fmaxf(__builtin_fmaxf(bb,PC1[r+2]),PC1[r+3]);} \
      rm=__builtin_fmaxf(a,bb); auto rr=__builtin_amdgcn_permlane32_swap(__float_as_uint(rm),__float_as_uint(rm),false,false); rm=__builtin_fmaxf(__uint_as_float(rr[0]),__uint_as_float(rr[1])); } \
    bool resc=false; \
      \
    if(FIRST){ mhat=rm;                                       \
      _Pragma("unroll") for(int r=0;r<16;++r){PC0[r]-=rm;PC1[r]-=rm;} \
      _Pragma("unroll") for(int r=0;r<16;++r)negm[r]=-mhat; asm volatile("":"+v"(negm)); } \
    else if(__any(rm>(float)THRL)){ const float dl=__builtin_fmaxf(rm,0.f); mhat+=dl;     \
      _Pragma("unroll") for(int r=0;r<16;++r){PC0[r]-=dl;PC1[r]-=dl;} \
      _Pragma("unroll") for(int r=0;r<16;++r)negm[r]=-mhat; asm volatile("":"+v"(negm)); \
      const float f=__builtin_amdgcn_exp2f(-dl); l_reg*=f; if(hi==0)wsf[r32]=f; resc=true; } \
    SBAR(); \
      \
    _Pragma("unroll") for(int i=4;i<16;++i){ \
      if(HASPV&&i+2<16){ const int g=i+2, jj=g&3, ks=g>>2; const lds_cptr vp=((jj>>1)?vpB:vpA)+((jj&1)*4096+ks*1024); fl[g&3]=vtr(vp); fh[g&3]=vtr(vp+512); } \
      if(HASQK){ const int q=(i<8)?(i-4):(((i&1)==0)?(4+((i-8)>>1)):-1); \
        if(q>=0){ if(q+1<8) kf[(q+1)&1]=KLD(kp,q+1); const int d0=q>>1; \
          if((q&1)==0) PN0=__builtin_amdgcn_mfma_f32_32x32x16_bf16(kf[q&1],qr[d0],(q<2)?negm:PN0,0,0,0); else PN1=__builtin_amdgcn_mfma_f32_32x32x16_bf16(kf[q&1],qr[d0],(q<2)?negm:PN1,0,0,0); } } \
      if(HASPV){ const int jj=i&3, ks=i>>2; o[jj]=__builtin_amdgcn_mfma_f32_32x32x16_bf16(__builtin_bit_cast(bf16x8,pw[ks]),PKV(fl[i&3],fh[i&3]),o[jj],0,0,0); } \
      if(i<8){ const int b0_=4*(i-4); float e0=__builtin_amdgcn_exp2f(PC0[b0_]),e1=__builtin_amdgcn_exp2f(PC0[b0_+1]),e2=__builtin_amdgcn_exp2f(PC0[b0_+2]),e3=__builtin_amdgcn_exp2f(PC0[b0_+3]); \
        PC0[b0_]=e0;PC0[b0_+1]=e1;PC0[b0_+2]=e2;PC0[b0_+3]=e3; sacc+=e0; sacc+=e1; sacc+=e2; sacc+=e3; PIN(sacc); } \
      else { const int b1_=2*i-16; float e0=__builtin_amdgcn_exp2f(PC1[b1_]),e1=__builtin_amdgcn_exp2f(PC1[b1_+1]); PC1[b1_]=e0;PC1[b1_+1]=e1; sacc+=e0; sacc+=e1; PIN(sacc); } \
      if(i==6||i==7){ const int w=2*(i-6); pw[0][w]=cvtpk_s(PC0[2*w],PC0[2*w+1]); pw[0][w+1]=cvtpk_s(PC0[2*w+2],PC0[2*w+3]); PIN(pw[0]); } \
      if(i==8||i==9){ const int w=2*(i-8); pw[1][w]=cvtpk_s(PC0[8+2*w],PC0[8+2*w+1]); pw[1][w+1]=cvtpk_s(PC0[8+2*w+2],PC0[8+2*w+3]); PIN(pw[1]); } \
      if(i==12||i==13){ const int w=2*(i-12); pw[2][w]=cvtpk_s(PC1[2*w],PC1[2*w+1]); pw[2][w+1]=cvtpk_s(PC1[2*w+2],PC1[2*w+3]); PIN(pw[2]); } \
      SBAR(); \
    } \
    _Pragma("unroll") for(int w=0;w<4;++w)pw[3][w]=cvtpk_s(PC1[8+2*w],PC1[8+2*w+1]); \
    l_reg+=sacc; \
    if(resc){ asm volatile("s_waitcnt lgkmcnt(0)":::"memory"); \
      _Pragma("unroll") for(int r=0;r<16;++r){ const float fr_=wsf[crow(r,hi)]; \
        _Pragma("unroll") for(int d_=0;d_<4;++d_)o[d_][r]*=fr_; } \
      asm volatile("s_waitcnt lgkmcnt(0)":::"memory"); } \
    if(HASQK){ const int jb=(t)+1-(NT-4); if(jb>=0)cmask(PN0,PN1,jb,qrel,hi); } \
  }while(0)
  f32x16 negm=f32x16{}; asm volatile("":"+v"(negm));
  if(wid>=4)__builtin_amdgcn_s_setprio(1);
  f32x16 pA0,pA1,pB0,pB1;
  if(pre){WAIT_BAR(0);}else{WAIT_BAR(6);}
  qkt0(pA0,pA1,Kbase,qr,r32,hi);
  { const int jb=0-(NT-4); if(jb>=0)cmask(pA0,pA1,jb,qrel,hi); }
  STEP2(pA0,pA1,pB0,pB1,0,true,false,true,0);
  int t=1;
  for(;t+1<NT;t+=2){
    STEP2(pB0,pB1,pA0,pA1,t,false,true,true,0);
    STEP2(pA0,pA1,pB0,pB1,t+1,false,true,true,0);
  }
  STEP2(pB0,pB1,pA0,pA1,t,false,true,false,1);
  { const int vs_=((NT-1)&3)*SLOTB; const lds_cptr vpA=vpA0+vs_, vpB=vpB0+vs_;
    #pragma unroll
    for(int jj=0;jj<4;++jj){ const lds_cptr vb_=((jj>>1)?vpB:vpA)+(jj&1)*4096; s16x4 l_[4],h_[4];
      #pragma unroll
      for(int ks=0;ks<4;++ks){ l_[ks]=vtr(vb_+ks*1024); h_[ks]=vtr(vb_+ks*1024+512); }
      #pragma unroll
      for(int ks=0;ks<4;++ks)o[jj]=__builtin_amdgcn_mfma_f32_32x32x16_bf16(__builtin_bit_cast(bf16x8,pw[ks]),PKV(l_[ks],h_[ks]),o[jj],0,0,0); } }
  #undef STEP2
  #undef KLD
  #undef PIN
  #undef PKV
  #undef DMAV
  #undef DMAK
  #undef RFL
  __builtin_amdgcn_s_setprio(0);
  {auto rr=__builtin_amdgcn_permlane32_swap(__float_as_uint(l_reg),__float_as_uint(l_reg),false,false);l_reg=__uint_as_float(rr[0])+__uint_as_float(rr[1]);}
  if(hi==0)wsf[32+r32]=l_reg;asm volatile("s_waitcnt lgkmcnt(0)":::"memory");
  float rli[16];
  #pragma unroll
  for(int r=0;r<16;++r)rli[r]=__builtin_amdgcn_rcpf(wsf[32+crow(r,hi)]);
  const char*we_=mk_ws_ptr();
  bf16*Ow=(bf16*)(we_+o_off)+(rowbase+q0+wid*QBLK)*DM+ocol;
  bf16*stg=(bf16*)(shm+U2_OST)+wid*2048;
  #pragma unroll
  for(int r=0;r<16;++r){
    #pragma unroll
    for(int jj=0;jj<4;++jj)o[jj][r]*=rli[r];}
  if(MODE==1){
    const float*sub_g=mk_in_ptr(subg_idx);
    #pragma unroll
    for(int h2=0;h2<2;++h2){
      #pragma unroll
      for(int i=0;i<4;++i){const int row=i*8+(lane>>3),ch=lane&7; *(u32x4*)(stg+row*64+ch*8)=g0_[h2][i];}
      asm volatile("s_waitcnt lgkmcnt(0)":::"memory");
      #pragma unroll
      for(int r=0;r<16;++r){const int orow=crow(r,hi);
        #pragma unroll
        for(int d0=0;d0<2;++d0){ const float o0=__bfloat162float(stg[orow*64+d0*32+r32]); o[2*h2+d0][r]=o0-lam*o[2*h2+d0][r]; } }
      asm volatile("s_waitcnt lgkmcnt(0)":::"memory");
    }
    float sgv[4];
    #pragma unroll
    for(int jj=0;jj<4;++jj)sgv[jj]=sub_g[jj*32+r32]*(1.0f-0.35550906759096934f);
    #pragma unroll
    for(int r=0;r<16;++r){ float ss=(o[0][r]*o[0][r]+o[1][r]*o[1][r])+(o[2][r]*o[2][r]+o[3][r]*o[3][r]);
      ss+=__shfl_xor(ss,1); ss+=__shfl_xor(ss,2); ss+=__shfl_xor(ss,4); ss+=__shfl_xor(ss,8); ss+=__shfl_xor(ss,16);
      const float sc_=1.0f/sqrtf(ss*(1.0f/128.0f)+1e-5f);
      #pragma unroll
      for(int jj=0;jj<4;++jj)o[jj][r]*=sc_*sgv[jj]; }
  }
  #pragma unroll
  for(int h2=0;h2<2;++h2){
    #pragma unroll
    for(int r=0;r<16;++r){const int orow=crow(r,hi);
      #pragma unroll
      for(int d0=0;d0<2;++d0)stg[orow*64+d0*32+r32]=__float2bfloat16(o[2*h2+d0][r]);}
    asm volatile("s_waitcnt lgkmcnt(0)":::"memory");
    #pragma unroll
    for(int i=0;i<4;++i){const int row=i*8+(lane>>3),ch=lane&7; const u32x4 v=*(const u32x4*)(stg+row*64+ch*8); ATTN_STORE16(Ow+(long)row*DM+h2*64+ch*8,v);}
    asm volatile("s_waitcnt lgkmcnt(0)":::"memory");
  }
  if(MODE==0)asm volatile("s_waitcnt vmcnt(0)":::"memory");
  asm volatile("s_waitcnt lgkmcnt(0)\n\ts_barrier":::"memory");
}
struct AttnUnit { int b, hc, vh, qb; };
__device__ __forceinline__ bool attn_next(int i,int G,int vcu,AttnUnit&u){
  const int L=i*G+vcu; if(L>=4096)return false;
  int combo,qb;
  if(G==256){ const int x=vcu>>5, c=vcu&31; combo=16*x+i; qb=(i&1)?31-c:c; }
  else { const int v=L&255, ii=L>>8, s=v&1, x=2*(ii>>1)+s; combo=v>>1; qb=(ii&1)?31-x:x; }
  u.qb=qb; u.vh=combo&1; u.hc=(combo>>1)&15; u.b=combo>>5; return true;
}
template<int THRL=8> __device__ __forceinline__ void attn_phase(char*lds,const bf16*Q,const bf16*K,const bf16*V,bf16*O0,bf16*O1,int G,int vcu){
  AttnUnit u;
  for(int i=0;attn_next(i,G,vcu,u);++i){
    const int vcol=(u.hc>>1)*128+u.vh*64;
    attn_unit<THRL>(u.b,u.hc*64,u.hc*64,vcol,vcol,u.qb,Q,K,V,(u.hc&1)?O1:O0,lds);
  }
}
__device__ __forceinline__ bool attn_next2(int i,int G,int vcu,int&bb,int&h,int&qb){
  const int L=i*G+vcu; if(L>=1024)return false;
  int hg;
  if(G==256){ const int x=vcu>>5, c=vcu&31; hg=4*x+i; qb=(i&1)?31-c:c; }
  else { hg=L>>5; qb=L&31; }
  h=hg&7; bb=hg>>3; return true;
}
template<int THRL=8> __device__ __forceinline__ void attn_phase2(char*lds,size_t q_off,size_t k_off,size_t v_off,size_t o0_off,size_t at_off,int lamq_idx,int lamk_idx,int subg_idx,int G,int vcu){
  const int lane=threadIdx.x&63;
  float lam;
  { const float*lam_q=mk_in_ptr(lamq_idx); const float*lam_k=mk_in_ptr(lamk_idx);
    float d0=lam_q[lane]*lam_k[lane], d1=lam_q[64+lane]*lam_k[64+lane];
    #pragma unroll
    for(int o_=1;o_<64;o_<<=1){ d0+=__shfl_xor(d0,o_); d1+=__shfl_xor(d1,o_); }
    lam=expf(d0)-expf(d1)+0.35550906759096934f; }
  int bb,h,qb; bf16x8 qr[4]; bool pre=false;
  #pragma unroll
  for(int d0=0;d0<4;++d0)qr[d0]=bf16x8{};
  for(int i=0;attn_next2(i,G,vcu,bb,h,qb);++i){
    const int vcol=h*128; int nb_=0,nh_=0,nq_=0; const bool hn=attn_next2(i+1,G,vcu,nb_,nh_,nq_);
    attn_unit2<THRL,0>(bb,(2*h)*64,(2*h)*64,vcol,vcol,qb,q_off,k_off,v_off,o0_off,0,subg_idx,lds,0.f, qr,pre,true,bb,(2*h+1)*64,(2*h+1)*64,vcol,qb);
    attn_unit2<THRL,1>(bb,(2*h+1)*64,(2*h+1)*64,vcol,vcol,qb,q_off,k_off,v_off,at_off,o0_off,subg_idx,lds,lam, qr,true,hn,nb_,(2*nh_)*64,(2*nh_)*64,nh_*128,nq_);
    pre=true;
  }
}
#undef SBAR
#undef WAIT_BAR
}

constexpr int NWAVES = 8;
#ifndef REP_DEFAULTS
constexpr int REP_P0 = 1, REP_P1 = 1, REP_P2 = 1, REP_P3 = 1, REP_P4 = 1, REP_P5 = 1, REP_P6 = 1, REP_P7 = 1, REP_P7b = 1, REP_P8 = 1, REP_P9 = 1, REP_P10 = 1, REP_P11 = 1, REP_SYNC = 1;
#endif
constexpr size_t MiB = 1u << 20;
constexpr size_t WS_CTL = 0;
constexpr size_t WS_ROPE = 1 * MiB;
constexpr size_t WS_WSB = 1 * MiB + 512 * 1024;
constexpr size_t WS_RMS = 2 * MiB;
constexpr size_t WS_LNS = 4 * MiB;
constexpr size_t WS_W = 12 * MiB;
constexpr size_t WO_IN = 0, WO_OUT = 8 * MiB, WO_GU0 = 12 * MiB, WO_DN0 = 23 * MiB, WO_KVQ = 28 * MiB + 512 * 1024, WO_O = 34 * MiB + 512 * 1024, WO_GU1 = 36 * MiB + 512 * 1024, WO_DN1 = 47 * MiB + 512 * 1024;
constexpr size_t WS_HB = 72 * MiB;
constexpr size_t WS_A = 136 * MiB;
constexpr size_t A_U = 0, A_V = 128 * MiB;
constexpr size_t A_ACT = 0;
constexpr size_t A_K = 0, A_VV = 64 * MiB, A_Q = 128 * MiB, A_O0 = 192 * MiB, A_O1 = 256 * MiB, A_AT = 256 * MiB;
constexpr size_t WS_END = WS_A + 320 * MiB;
constexpr int RING_OFF = 0, RING_BYTES = 131072;
constexpr int LDS_BYTES = 147456;
constexpr int MISC_OFF = RING_BYTES + 320;

#define GAS __attribute__((address_space(1)))
#define LAS __attribute__((address_space(3)))
typedef unsigned short bf16;
typedef unsigned v4u __attribute__((ext_vector_type(4)));
typedef float f32x4 __attribute__((ext_vector_type(4)));
typedef float f32x16 __attribute__((ext_vector_type(16)));
typedef short bf16x8 __attribute__((ext_vector_type(8)));
#define LDS_WAIT() asm volatile("s_waitcnt lgkmcnt(0)" ::: "memory")
__device__ __forceinline__ unsigned f2bf(float f) { unsigned u = __builtin_bit_cast(unsigned, f); return (u + 0x7fffu + ((u >> 16) & 1u)) >> 16; }
__device__ __forceinline__ unsigned pk2(float lo, float hi) { return f2bf(lo) | (f2bf(hi) << 16); }
__device__ __forceinline__ float bflo(unsigned w) { return __uint_as_float(w << 16); }
__device__ __forceinline__ float bfhi(unsigned w) { return __uint_as_float(w & 0xffff0000u); }
__device__ __forceinline__ float wave_sum(float v) {
#pragma unroll
    for (int o = 1; o < 64; o <<= 1) v += __shfl_xor(v, o);
    return v;
}
struct P0Item { const float* W; bf16* WT; const float* kscale; int K, N, row_off, mode, item; };
__device__ __forceinline__ void p0_item_load(const P0Item& d, float (&wv)[32], int lane) {
    const int nblk = d.N / 32, kb = d.item / nblk, nb = d.item % nblk, k0 = 64 * kb, n0 = 32 * nb;
#pragma unroll
    for (int i = 0; i < 32; ++i) wv[i] = d.W[(size_t)(k0 + 2 * i + (lane >> 5)) * d.N + n0 + (lane & 31)];
}
__device__ __forceinline__ void p0_item_store(const P0Item& d, float (&wv)[32], LAS float* scr, int lane) {
    const int K = d.K, nblk = d.N / 32, kb = d.item / nblk, nb = d.item % nblk, k0 = 64 * kb, n0 = 32 * nb;
    if (d.kscale) {
#pragma unroll
        for (int i = 0; i < 32; ++i) wv[i] *= d.kscale[k0 + 2 * i + (lane >> 5)]; }
#pragma unroll
    for (int i = 0; i < 32; ++i) scr[(2 * i + (lane >> 5)) * 33 + (lane & 31)] = wv[i];
    LDS_WAIT(); asm volatile("" ::: "memory");
    int d0 = d.row_off + n0;
    if (d.mode == 1) { const int half = n0 / DFF, r = n0 % DFF; d0 = 256 * (r / 128) + 128 * half + (r % 128); }
    const int c = lane & 7;
#pragma unroll
    for (int j = 0; j < 4; ++j) { const int n = (lane >> 3) + 8 * j; const LAS float* s = scr + (8 * c) * 33 + n;
        v4u o; o.x = pg8::cvt_pk_bf16(s[0 * 33], s[1 * 33]); o.y = pg8::cvt_pk_bf16(s[2 * 33], s[3 * 33]); o.z = pg8::cvt_pk_bf16(s[4 * 33], s[5 * 33]); o.w = pg8::cvt_pk_bf16(s[6 * 33], s[7 * 33]);
        *(GAS v4u*)(d.WT + (size_t)(d0 + n) * K + k0 + 8 * c) = o; }
    LDS_WAIT(); asm volatile("" ::: "memory");
}
#define RLX_AGENT __ATOMIC_RELAXED, __HIP_MEMORY_SCOPE_AGENT
#define XB_TMO      128
#define XB_XCNT(j)  (256  + 64 * (j))
#define XB_XSUB(j)  (1280 + 64 * (j))
#define XB_XGEN(j)  (2304 + 64 * (j))
#define XB_TOP      3328
#define XB_TOPGEN   3392
#define XCD_BAR_WORDS 3456
#define XB_SPIN_CAP (1u << 18)

__device__ __forceinline__ unsigned xb_ld(unsigned* p)              { return __hip_atomic_load(p, __ATOMIC_RELAXED, __HIP_MEMORY_SCOPE_AGENT); }
__device__ __forceinline__ unsigned xb_add(unsigned* p, unsigned v) { return __hip_atomic_fetch_add(p, v, __ATOMIC_RELAXED, __HIP_MEMORY_SCOPE_AGENT); }
__device__ __forceinline__ unsigned xb_xcc_id() { return (unsigned)__builtin_amdgcn_s_getreg((3 << 11) | 20) & 0xFu; }
#define XB_SPIN(cond, bar) do { unsigned _sp = 0; while (cond) { __builtin_amdgcn_s_sleep(1); \
    if ((++_sp & 255u) == 0u) { if (xb_ld(&(bar)[XB_TMO])) break; if (_sp > XB_SPIN_CAP) { atomicAdd(&(bar)[XB_TMO], 1u); break; } } } } while (0)

struct XcdBarrier {
    unsigned* bar; unsigned x;
    volatile LAS unsigned* st;
};

__device__ __forceinline__ XcdBarrier xcd_barrier_post(unsigned* bar, volatile LAS unsigned* st) {
    XcdBarrier b; b.bar = bar; b.x = xb_xcc_id(); b.st = st;
    if (threadIdx.x == 0) (void)xb_add(&bar[XB_XCNT(b.x)], 1u);
    return b;
}
__device__ __forceinline__ void xcd_barrier_complete(unsigned* bar, unsigned x, unsigned& nloc, unsigned& nx) {
    const unsigned G = gridDim.x * gridDim.y * gridDim.z;
    unsigned sum, cnt, mine, sp = 0u;
    for (;;) {
        sum = 0u; cnt = 0u; mine = 0u;
#pragma unroll
        for (unsigned j = 0; j < 16; ++j) { const unsigned c = xb_ld(&bar[XB_XCNT(j)]); sum += c; cnt += (c > 0u) ? 1u : 0u; mine = (j == x) ? c : mine; }
        if (sum == G) break;
        __builtin_amdgcn_s_sleep(1);
        if ((++sp & 255u) == 0u) { if (xb_ld(&bar[XB_TMO])) break; if (sp > XB_SPIN_CAP) { atomicAdd(&bar[XB_TMO], 1u); break; } }
    }
    nloc = mine > 0u ? mine : 1u; nx = cnt > 0u ? cnt : 1u;
}

__device__ __forceinline__ void xcd_barrier(const XcdBarrier& b) {
    asm volatile("s_waitcnt vmcnt(0)" ::: "memory");
    __syncthreads();
    if (threadIdx.x == 0) {
        unsigned* bar = b.bar;
        __builtin_amdgcn_s_waitcnt(0);
        unsigned nloc = b.st[0], nx = b.st[1];
        if (nloc == 0u) { xcd_barrier_complete(bar, b.x, nloc, nx); b.st[0] = nloc; b.st[1] = nx; }
        const unsigned old = xb_add(&bar[XB_XSUB(b.x)], 1u);
        const unsigned gen = old / nloc;
        if (old + 1u == (gen + 1u) * nloc) {
            __builtin_amdgcn_fence(__ATOMIC_RELEASE, "agent");
            asm volatile("s_waitcnt vmcnt(0)" ::: "memory");
            const unsigned og = xb_add(&bar[XB_TOP], 1u);
            const unsigned tg = og / nx;
            if (og + 1u == (tg + 1u) * nx) xb_add(&bar[XB_TOPGEN], 1u);
            else XB_SPIN(xb_ld(&bar[XB_TOPGEN]) == tg, bar);
            __builtin_amdgcn_fence(__ATOMIC_ACQUIRE, "agent");
            asm volatile("s_waitcnt vmcnt(0)" ::: "memory");
        } else {
            XB_SPIN(xb_ld(&bar[XB_TOPGEN]) == gen, bar);
            __builtin_amdgcn_fence(__ATOMIC_ACQUIRE, "agent");
            asm volatile("s_waitcnt vmcnt(0)" ::: "memory");
        }
    }
    __syncthreads();
}
struct Args { const float* in[19]; float* out; unsigned char* ws; };
enum { I_X = 0, I_ATTN_G, I_FFN_G, I_W_IN, I_LN_G, I_LN_B, I_W_S, I_B_S, I_W_OUT, I_KV_G, I_W_KV, I_W_Q, I_LAM_Q, I_LAM_K, I_SUB_G, I_W_O, I_W_GU, I_W_DOWN, I_FINAL_G };

typedef const Args __attribute__((address_space(4)))* KArgs;
namespace attn_body {
__device__ __forceinline__ const char* mk_ws_ptr() { KArgs p_ = (KArgs)__builtin_amdgcn_kernarg_segment_ptr(); asm volatile("" : "+s"(p_)); return (const char*)p_->ws; }
__device__ __forceinline__ const float* mk_in_ptr(int k) { KArgs p_ = (KArgs)__builtin_amdgcn_kernarg_segment_ptr(); asm volatile("" : "+s"(p_)); return p_->in[k]; }
}
#define PHASE_BEGIN() KArgs A_; { KArgs p_ = (KArgs)__builtin_amdgcn_kernarg_segment_ptr(); asm volatile("" : "+s"(p_)); A_ = p_; } \
    unsigned char* ws = A_->ws; int tid = threadIdx.x; asm volatile("" : "+v"(tid)); const int lane = tid & 63, wave = __builtin_amdgcn_readfirstlane(tid >> 6); (void)lane; (void)wave; (void)ws
#define IN_(k) (A_->in[k])
#define WSB_(off) ((bf16*)(ws + (off)))
#define WSF_(off) ((float*)(ws + (off)))
__global__ void __launch_bounds__(NWAVES * 64, 2) mk_fwd(Args args) {
    extern __shared__ __attribute__((aligned(16))) unsigned char lds_raw[];
    cg::grid_group grid = cg::this_grid();
    LAS unsigned char* lds = (LAS unsigned char*)lds_raw;
    const int G = gridDim.x; const int bx = blockIdx.x; const int vcu = (G % 8 == 0) ? (bx % 8) * (G / 8) + bx / 8 : bx;
    const int NGW = G * NWAVES;
    for (int u = threadIdx.x; u < 32; u += NWAVES * 64) ((LAS unsigned*)(lds + MISC_OFF))[u] = 0u;
    __syncthreads();
#define GRID_BAR() do { KArgs p_ = (KArgs)__builtin_amdgcn_kernarg_segment_ptr(); asm volatile("" : "+s"(p_)); XcdBarrier b_; b_.bar = (unsigned*)(p_->ws + WS_CTL); b_.x = xb_xcc_id(); b_.st = (volatile LAS unsigned*)(lds + MISC_OFF) + 8; xcd_barrier(b_); } while (0)

    for (int rep_ = 0; rep_ < REP_P0; ++rep_)
    {
        PHASE_BEGIN(); const int gw = vcu * NWAVES + wave;
        LAS float* scr = (LAS float*)(lds + RING_OFF + wave * 16384);
        float* rope = WSF_(WS_ROPE); bf16* Wsb = WSB_(WS_WSB); bf16* HB = WSB_(WS_HB);
        bf16 *W_in_t = WSB_(WS_W + WO_IN), *W_out_t = WSB_(WS_W + WO_OUT), *W_gu0_t = WSB_(WS_W + WO_GU0), *W_dn0_t = WSB_(WS_W + WO_DN0), *W_kvq_t = WSB_(WS_W + WO_KVQ), *W_o_t = WSB_(WS_W + WO_O), *W_gu1_t = WSB_(WS_W + WO_GU1), *W_dn1_t = WSB_(WS_W + WO_DN1);
        constexpr int IT_IN = (DMODEL / 64) * (4096 / 32), IT_OUT = (GWIDTH / 64) * (DMODEL / 32), IT_GU = (DMODEL / 64) * (2 * DFF / 32), IT_DN = (DFF / 64) * (DMODEL / 32),
                      IT_KV = (DMODEL / 64) * (2048 / 32), IT_Q = (DMODEL / 64) * (DMODEL / 32), IT_O = IT_Q;
        constexpr int NITEMS = IT_IN + IT_OUT + 2 * IT_GU + 2 * IT_DN + IT_KV + IT_Q + IT_O;
        const float* ffn_g = IN_(I_FFN_G);
#define P0_DESC(D, IT) do { int r = (IT); \
            if (r < IT_IN) { D = P0Item{IN_(I_W_IN), W_in_t, nullptr, DMODEL, 4096, 0, 0, r}; break; } r -= IT_IN; \
            if (r < IT_OUT) { D = P0Item{IN_(I_W_OUT), W_out_t, nullptr, GWIDTH, DMODEL, 0, 0, r}; break; } r -= IT_OUT; \
            if (r < IT_GU) { D = P0Item{IN_(I_W_GU), W_gu0_t, ffn_g, DMODEL, 2 * DFF, 0, 1, r}; break; } r -= IT_GU; \
            if (r < IT_GU) { D = P0Item{IN_(I_W_GU) + (size_t)DMODEL * 2 * DFF, W_gu1_t, ffn_g + DMODEL, DMODEL, 2 * DFF, 0, 1, r}; break; } r -= IT_GU; \
            if (r < IT_DN) { D = P0Item{IN_(I_W_DOWN), W_dn0_t, nullptr, DFF, DMODEL, 0, 0, r}; break; } r -= IT_DN; \
            if (r < IT_DN) { D = P0Item{IN_(I_W_DOWN) + (size_t)DFF * DMODEL, W_dn1_t, nullptr, DFF, DMODEL, 0, 0, r}; break; } r -= IT_DN; \
            if (r < IT_KV) { D = P0Item{IN_(I_W_KV), W_kvq_t, IN_(I_KV_G), DMODEL, 2048, 0, 0, r}; break; } r -= IT_KV; \
            if (r < IT_Q) { D = P0Item{IN_(I_W_Q), W_kvq_t, IN_(I_ATTN_G) + DMODEL, DMODEL, DMODEL, 2048, 0, r}; break; } r -= IT_Q; \
            D = P0Item{IN_(I_W_O), W_o_t, nullptr, DMODEL, DMODEL, 0, 0, r}; } while (0)
        { float wa[32], wb[32]; P0Item da, db; int it = gw;
          if (it < NITEMS) { P0_DESC(da, it); p0_item_load(da, wa, lane); }
          while (it < NITEMS) {
              const int i1 = it + NGW, i2 = it + 2 * NGW;
              if (i1 < NITEMS) { P0_DESC(db, i1); p0_item_load(db, wb, lane); }
              p0_item_store(da, wa, scr, lane);
              if (i1 >= NITEMS) break;
              if (i2 < NITEMS) { P0_DESC(da, i2); p0_item_load(da, wa, lane); }
              p0_item_store(db, wb, scr, lane);
              it = i2; } }
#undef P0_DESC
        { const float* x = IN_(I_X); const GAS f32x4* gp = (const GAS f32x4*)IN_(I_ATTN_G) + lane;
          f32x4 gv[4];
#pragma unroll
          for (int j = 0; j < 4; ++j) gv[j] = gp[64 * j];
          for (int m0 = gw; m0 < MROWS; m0 += 8 * NGW) {
              f32x4 v[8][4]; float s2[8];
#pragma unroll
              for (int k = 0; k < 8; ++k) { const int m = (m0 + k * NGW < MROWS) ? m0 + k * NGW : m0; const GAS f32x4* xr = (const GAS f32x4*)(x + (size_t)m * DMODEL) + lane;
#pragma unroll
                  for (int j = 0; j < 4; ++j) v[k][j] = xr[64 * j]; }
#pragma unroll
              for (int k = 0; k < 8; ++k) { float s = 0.f;
#pragma unroll
                  for (int j = 0; j < 4; ++j) s += (v[k][j].x * v[k][j].x + v[k][j].y * v[k][j].y) + (v[k][j].z * v[k][j].z + v[k][j].w * v[k][j].w);
                  s2[k] = 1.f / sqrtf(wave_sum(s) * (1.f / DMODEL) + NORM_EPS); }
#pragma unroll
              for (int k = 0; k < 8; ++k) { const int m = m0 + k * NGW; if (m < MROWS) { GAS unsigned long long* o8 = (GAS unsigned long long*)(HB + (size_t)m * DMODEL) + lane;
#pragma unroll
                  for (int j = 0; j < 4; ++j) { const f32x4 y = v[k][j] * s2[k] * gv[j]; o8[64 * j] = (unsigned long long)pg8::cvt_pk_bf16(y.x, y.y) | ((unsigned long long)pg8::cvt_pk_bf16(y.z, y.w) << 32); } } }
          } }
        { const int idx = bx * (NWAVES * 64) + tid;
          if (idx < SEQLEN * 8) { const int pos = idx >> 3, i = idx & 7;
              const float invf = (i == 0) ? 1.0f : (i == 1) ? 0.1939227432012558f : (i == 2) ? 0.03760603070259094f : (i == 3) ? 0.007292664609849453f : (i == 4) ? 0.0014142135623842478f
                               : (i == 5) ? 0.00027424818836152554f : (i == 6) ? 5.318296098266728e-05f : 1.0313386155758053e-05f;
              const float angf = (float)pos * invf; const double a = (double)angf;
              const double n = __builtin_rint(a * 0.15915494309189535); const double r = __builtin_fma(-n, 6.283185307179586, a) - n * 2.4492935982947064e-16;
              const double r2 = r * r; double sn = 1.0, cs = 1.0;
#pragma unroll
              for (int k = 14; k >= 1; --k) { sn = 1.0 - sn * r2 / (double)((2 * k) * (2 * k + 1)); cs = 1.0 - cs * r2 / (double)((2 * k - 1) * (2 * k)); }
              sn *= r;
              rope[pos * 16 + i] = (float)cs; rope[pos * 16 + 8 + i] = (float)sn; } }
        { const float* w_s = IN_(I_W_S);
          for (int idx = bx * (NWAVES * 64) + tid; idx < 8 * 128 * 128; idx += G * NWAVES * 64) { const int t = (idx >> 7) & 127, s = idx & 127; Wsb[idx] = (bf16)f2bf(s <= t ? w_s[idx] : 0.f); } }
    }
    { KArgs p_ = (KArgs)__builtin_amdgcn_kernarg_segment_ptr(); asm volatile("" : "+s"(p_)); unsigned* bw_ = (unsigned*)(p_->ws + WS_CTL);
      if (bx == 0) for (int u = threadIdx.x; u < XCD_BAR_WORDS; u += NWAVES * 64) __hip_atomic_store(bw_ + u, 0u, __ATOMIC_RELAXED, __HIP_MEMORY_SCOPE_AGENT); }
    for (int rs_ = 0; rs_ < REP_SYNC; ++rs_) grid.sync();
    { KArgs p_ = (KArgs)__builtin_amdgcn_kernarg_segment_ptr(); asm volatile("" : "+s"(p_)); (void)xcd_barrier_post((unsigned*)(p_->ws + WS_CTL), (volatile LAS unsigned*)(lds + MISC_OFF) + 8); }


#ifndef SKIP_P1
    for (int rep_ = 0; rep_ < REP_P1; ++rep_)
    { PHASE_BEGIN(); pg8::Gemm g{WSB_(WS_HB), WSB_(WS_W + WO_IN), MROWS, 4096, DMODEL}; pg8::StaticOrder S; S.init(MROWS, 4096, G, bx);
      pg8::EpiGeluUV E{WSB_(WS_A + A_U), WSF_(WS_LNS)};
      pg8::gemm_phase<pg8::EpiGeluUV, pg8::StaticOrder, true, true>(lds + RING_OFF, g, S, E); }
#endif
    for (int rs_ = 0; rs_ < REP_SYNC; ++rs_) GRID_BAR();
#ifndef SKIP_P2
    for (int rep_ = 0; rep_ < REP_P2; ++rep_)
    {
        PHASE_BEGIN(); bf16* Ub = WSB_(WS_A + A_U); const bf16* Vb = WSB_(WS_A + A_V); const float* lns = WSF_(WS_LNS); const bf16* Wsb = WSB_(WS_WSB);
#define P2_BAR() asm volatile("s_waitcnt lgkmcnt(0)\n\ts_barrier" ::: "memory")
        constexpr int RS = 528;
        LAS unsigned char* Tl = lds + RING_OFF; LAS float* MS = (LAS float*)(lds + RING_OFF + 128 * RS);
        const float* ln_g = IN_(I_LN_G); const float* ln_b = IN_(I_LN_B); const float* b_s = IN_(I_B_S);
        const int cc = tid & 31, rr = tid >> 5, j = lane & 31, kg = lane >> 5;
        constexpr int WRS = 272;
        LAS unsigned char* WsL = lds + RING_OFF + 69632; LAS float* bsL = (LAS float*)(lds + RING_OFF + 69632 + 128 * WRS);
        int g_loaded = -1; f32x4 g0 = {0.f, 0.f, 0.f, 0.f}, g1 = g0, b0 = g0, b1 = g0;
        f32x4 sa = {0.f, 0.f, 0.f, 0.f}, sb = sa, sc = sa, sd = sa; v4u vraw[8];
#pragma unroll
        for (int p = 0; p < 8; ++p) vraw[p] = (v4u){0u, 0u, 0u, 0u};
#define P2_PREFETCH(UI) do { const int cb_ = (UI) >> 3, g_ = (UI) & 7; const size_t r0_ = (size_t)cb_ * 128; \
            const f32x4* sp_ = (const f32x4*)(lns + (r0_ + (tid >> 2)) * 64 + (tid & 3) * 16); sa = sp_[0]; sb = sp_[1]; sc = sp_[2]; sd = sp_[3]; \
            _Pragma("unroll") for (int p = 0; p < 8; ++p) vraw[p] = *(const v4u*)(Vb + (r0_ + p * 16 + rr) * GWIDTH + g_ * 256 + cc * 8); } while (0)
        if (vcu < 2048) P2_PREFETCH(vcu);
        for (int uidx = vcu; uidx < 2048; uidx += G) {
            const int cb = uidx >> 3, g = uidx & 7; const size_t row0 = (size_t)cb * 128;
            if (g != g_loaded) {
#pragma unroll
                for (int i = 0; i < 4; ++i) { const int idx = tid + 512 * i, row = idx >> 4, ch = idx & 15;
                    *(LAS v4u*)(WsL + row * WRS + ch * 16) = *(const v4u*)(Wsb + (size_t)g * 128 * 128 + row * 128 + ch * 8); }
                if (tid < 128) bsL[tid] = b_s[g * 128 + tid];
                const float* gp = ln_g + g * 256 + cc * 8; const float* bp = ln_b + g * 256 + cc * 8;
                g0 = *(const f32x4*)gp; g1 = *(const f32x4*)(gp + 4); b0 = *(const f32x4*)bp; b1 = *(const f32x4*)(bp + 4);
                g_loaded = g; }
            { const int r = tid >> 2, part = tid & 3;
              float s = ((sa[0] + sa[2]) + (sb[0] + sb[2])) + ((sc[0] + sc[2]) + (sd[0] + sd[2])), q = ((sa[1] + sa[3]) + (sb[1] + sb[3])) + ((sc[1] + sc[3]) + (sd[1] + sd[3]));
              s += __shfl_xor(s, 1); s += __shfl_xor(s, 2); q += __shfl_xor(q, 1); q += __shfl_xor(q, 2);
              const float mean = s * (1.f / GWIDTH), var = fmaxf(q * (1.f / GWIDTH) - mean * mean, 0.f);
              if (part == 0) { MS[2 * r] = mean; MS[2 * r + 1] = 1.f / sqrtf(var + NORM_EPS); } }
            P2_BAR();
            {
#pragma unroll
              for (int p = 0; p < 8; ++p) { const int row = p * 16 + rr;
                  const v4u raw = vraw[p];
                  const float mean = MS[2 * row], rstd = MS[2 * row + 1];
                  f32x4 x0 = {bflo(raw.x), bfhi(raw.x), bflo(raw.y), bfhi(raw.y)}, x1 = {bflo(raw.z), bfhi(raw.z), bflo(raw.w), bfhi(raw.w)};
                  x0 = (x0 - mean) * rstd * g0 + b0; x1 = (x1 - mean) * rstd * g1 + b1;
                  v4u w; w.x = pg8::cvt_pk_bf16(x0[0], x0[1]); w.y = pg8::cvt_pk_bf16(x0[2], x0[3]); w.z = pg8::cvt_pk_bf16(x1[0], x1[1]); w.w = pg8::cvt_pk_bf16(x1[2], x1[3]);
                  *(LAS v4u*)(Tl + row * RS + cc * 16) = w; } }
            P2_BAR();
            if (uidx + G < 2048) P2_PREFETCH(uidx + G);
            v4u ur[8];
#pragma unroll
            for (int p = 0; p < 8; ++p) ur[p] = *(const v4u*)(Ub + (row0 + p * 16 + rr) * GWIDTH + g * 256 + cc * 8);
            f32x16 acc[4];
#pragma unroll
            for (int mt = 0; mt < 4; ++mt)
#pragma unroll
                for (int r = 0; r < 16; ++r) acc[mt][r] = 0.f;
#pragma unroll
            for (int ks = 0; ks < 8; ++ks) {
                const LAS unsigned short* bp = (const LAS unsigned short*)(Tl + (16 * ks + 8 * kg) * RS) + 32 * wave + j;
                bf16x8 bfr;
#pragma unroll
                for (int e = 0; e < 8; ++e) bfr[e] = (short)bp[e * (RS / 2)];
#pragma unroll
                for (int mt = 0; mt < 4; ++mt) if (ks <= 2 * mt + 1) {
                    const bf16x8 afr = *(const LAS bf16x8*)(WsL + (32 * mt + j) * WRS + (16 * ks + 8 * kg) * 2);
                    acc[mt] = __builtin_amdgcn_mfma_f32_32x32x16_bf16(bfr, afr, acc[mt], 0, 0, 0); }
                if (ks & 1) __builtin_amdgcn_sched_barrier(0);
            }
            P2_BAR();
#pragma unroll
            for (int mt = 0; mt < 4; ++mt) { const int tt = 32 * mt + j; const float bias = bsL[tt];
#pragma unroll
                for (int q = 0; q < 4; ++q) { typedef unsigned u32x2_t __attribute__((ext_vector_type(2)));
                    u32x2_t w; w.x = pg8::cvt_pk_bf16(acc[mt][4 * q] + bias, acc[mt][4 * q + 1] + bias); w.y = pg8::cvt_pk_bf16(acc[mt][4 * q + 2] + bias, acc[mt][4 * q + 3] + bias);
                    *(LAS u32x2_t*)(Tl + tt * RS + (32 * wave + 8 * q + 4 * kg) * 2) = w; } }
            P2_BAR();
#pragma unroll
            for (int p = 0; p < 8; ++p) { const int row = p * 16 + rr;
                bf16* up = Ub + (row0 + row) * GWIDTH + g * 256 + cc * 8;
                const v4u urp = ur[p]; const v4u mr = *(const LAS v4u*)(Tl + row * RS + cc * 16);
                v4u w; w.x = pg8::cvt_pk_bf16(bflo(urp.x) * bflo(mr.x), bfhi(urp.x) * bfhi(mr.x)); w.y = pg8::cvt_pk_bf16(bflo(urp.y) * bflo(mr.y), bfhi(urp.y) * bfhi(mr.y));
                w.z = pg8::cvt_pk_bf16(bflo(urp.z) * bflo(mr.z), bfhi(urp.z) * bfhi(mr.z)); w.w = pg8::cvt_pk_bf16(bflo(urp.w) * bflo(mr.w), bfhi(urp.w) * bfhi(mr.w));
                *(v4u*)up = w; }
            P2_BAR();
        }
#undef P2_PREFETCH
#undef P2_BAR
    }
#endif
    for (int rs_ = 0; rs_ < REP_SYNC; ++rs_) GRID_BAR();
#ifndef SKIP_P3
    for (int rep_ = 0; rep_ < REP_P3; ++rep_)
    { PHASE_BEGIN(); pg8::Gemm g{WSB_(WS_A + A_U), WSB_(WS_W + WO_OUT), MROWS, DMODEL, GWIDTH}; pg8::StaticOrder S; S.init(MROWS, DMODEL, G, bx);
      pg8::EpiRes<true, false> E{IN_(I_X), nullptr, nullptr, WSB_(WS_HB), WSF_(WS_RMS)};
      pg8::gemm_phase<pg8::EpiRes<true, false>, pg8::StaticOrder, true, true>(lds + RING_OFF, g, S, E); }
#endif
    for (int rs_ = 0; rs_ < REP_SYNC; ++rs_) GRID_BAR();
#ifndef SKIP_P4
    for (int rep_ = 0; rep_ < REP_P4; ++rep_)
    { PHASE_BEGIN(); pg8::Gemm g{WSB_(WS_HB), WSB_(WS_W + WO_GU0), MROWS, 2 * DFF, DMODEL}; pg8::StaticOrder S; S.init(MROWS, 2 * DFF, G, bx);
      pg8::EpiSwiglu E{WSB_(WS_A + A_ACT), WSF_(WS_RMS)};
      pg8::gemm_phase<pg8::EpiSwiglu, pg8::StaticOrder, true, true>(lds + RING_OFF, g, S, E); }
#endif
    for (int rs_ = 0; rs_ < REP_SYNC; ++rs_) GRID_BAR();
#ifndef SKIP_P5
    for (int rep_ = 0; rep_ < REP_P5; ++rep_)
    { PHASE_BEGIN(); pg8::Gemm g{WSB_(WS_A + A_ACT), WSB_(WS_W + WO_DN0), MROWS, DMODEL, DFF}; pg8::StaticOrder S; S.init(MROWS, DMODEL, G, bx);
      pg8::EpiRes<false, false> E{nullptr, WSB_(WS_HB), nullptr, WSB_(WS_HB), WSF_(WS_RMS)};
      pg8::gemm_phase<pg8::EpiRes<false, false>, pg8::StaticOrder, true, true>(lds + RING_OFF, g, S, E); }
#endif
    for (int rs_ = 0; rs_ < REP_SYNC; ++rs_) GRID_BAR();
#ifndef SKIP_P6
    for (int rep_ = 0; rep_ < REP_P6; ++rep_)
    { PHASE_BEGIN(); pg8::Gemm g{WSB_(WS_HB), WSB_(WS_W + WO_KVQ), MROWS, 3072, DMODEL}; pg8::StaticOrder S; S.init(MROWS, 3072, G, bx);
      pg8::EpiKVQ E{WSB_(WS_A + A_K), WSF_(WS_RMS), WSF_(WS_ROPE)};
      pg8::gemm_phase<pg8::EpiKVQ, pg8::StaticOrder, true, true>(lds + RING_OFF, g, S, E); }
#endif
    for (int rs_ = 0; rs_ < REP_SYNC; ++rs_) GRID_BAR();
#ifndef SKIP_P7
    for (int rep_ = 0; rep_ < REP_P7; ++rep_)
    { attn_body::attn_phase2<8>((char*)lds_raw + RING_OFF, WS_A + A_Q, WS_A + A_K, WS_A + A_VV, WS_A + A_O0, WS_A + A_AT, I_LAM_Q, I_LAM_K, I_SUB_G, G, vcu); }
#endif
    for (int rs_ = 0; rs_ < REP_SYNC; ++rs_) GRID_BAR();
#ifndef SKIP_P8
    for (int rep_ = 0; rep_ < REP_P8; ++rep_)
    { PHASE_BEGIN(); pg8::Gemm g{WSB_(WS_A + A_AT), WSB_(WS_W + WO_O), MROWS, DMODEL, DMODEL}; pg8::StaticOrder S; S.init(MROWS, DMODEL, G, bx);
      pg8::EpiRes<false, false> E{nullptr, WSB_(WS_HB), nullptr, WSB_(WS_HB), WSF_(WS_RMS)};
      pg8::gemm_phase<pg8::EpiRes<false, false>, pg8::StaticOrder, true, true>(lds + RING_OFF, g, S, E); }
#endif
    for (int rs_ = 0; rs_ < REP_SYNC; ++rs_) GRID_BAR();
#ifndef SKIP_P9
    for (int rep_ = 0; rep_ < REP_P9; ++rep_)
    { PHASE_BEGIN(); pg8::Gemm g{WSB_(WS_HB), WSB_(WS_W + WO_GU1), MROWS, 2 * DFF, DMODEL}; pg8::StaticOrder S; S.init(MROWS, 2 * DFF, G, bx);
      pg8::EpiSwiglu E{WSB_(WS_A + A_ACT), WSF_(WS_RMS)};
      pg8::gemm_phase<pg8::EpiSwiglu, pg8::StaticOrder, true, true>(lds + RING_OFF, g, S, E); }
#endif
    for (int rs_ = 0; rs_ < REP_SYNC; ++rs_) GRID_BAR();
#ifndef SKIP_P10
    for (int rep_ = 0; rep_ < REP_P10; ++rep_)
    { PHASE_BEGIN(); pg8::Gemm g{WSB_(WS_A + A_ACT), WSB_(WS_W + WO_DN1), MROWS, DMODEL, DFF}; pg8::StaticOrder S; S.init(MROWS, DMODEL, G, bx);
      pg8::EpiRes<false, false> E{nullptr, WSB_(WS_HB), nullptr, WSB_(WS_HB), WSF_(WS_RMS)};
      pg8::gemm_phase<pg8::EpiRes<false, false>, pg8::StaticOrder, true, true>(lds + RING_OFF, g, S, E); }
#endif
    for (int rs_ = 0; rs_ < REP_SYNC; ++rs_) GRID_BAR();
#ifndef SKIP_P11
    for (int rep_ = 0; rep_ < REP_P11; ++rep_)
    {
        PHASE_BEGIN(); const int gw = vcu * NWAVES + wave; float* out = A_->out; const float* rms = WSF_(WS_RMS); const bf16* HB = WSB_(WS_HB);
        const float* gp = IN_(I_FINAL_G) + lane * 16;
        f32x4 gv[4];
#pragma unroll
        for (int j = 0; j < 4; ++j) gv[j] = *(const f32x4*)(gp + 4 * j);
        for (int m0 = gw; m0 < MROWS; m0 += 8 * NGW) {
            v4u a[8][2]; float rs[8];
#pragma unroll
            for (int k = 0; k < 8; ++k) { const int m = (m0 + k * NGW < MROWS) ? m0 + k * NGW : m0; const v4u* p = (const v4u*)(HB + (size_t)m * DMODEL + lane * 16); a[k][0] = p[0]; a[k][1] = p[1]; }
#pragma unroll
            for (int k = 0; k < 8; ++k) { const int m = (m0 + k * NGW < MROWS) ? m0 + k * NGW : m0; rs[k] = pg8::row_rstd(rms, m); }
#pragma unroll
            for (int k = 0; k < 8; ++k) { const int m = m0 + k * NGW; if (m < MROWS) { const float rstd = rs[k]; const v4u a0 = a[k][0], a1 = a[k][1];
                f32x4* o = (f32x4*)(out + (size_t)m * DMODEL + lane * 16);
                o[0] = (f32x4){bflo(a0.x), bfhi(a0.x), bflo(a0.y), bfhi(a0.y)} * rstd * gv[0]; o[1] = (f32x4){bflo(a0.z), bfhi(a0.z), bflo(a0.w), bfhi(a0.w)} * rstd * gv[1];
                o[2] = (f32x4){bflo(a1.x), bfhi(a1.x), bflo(a1.y), bfhi(a1.y)} * rstd * gv[2]; o[3] = (f32x4){bflo(a1.z), bfhi(a1.z), bflo(a1.w), bfhi(a1.w)} * rstd * gv[3]; } }
        }
    }
#endif
}

extern "C" void kernel_launch(void* const* d_in, const int* in_sizes, int n_in, void* d_out, int out_size, void* d_ws, size_t ws_size, hipStream_t stream) {
    static int grid = 0;
    if (grid == 0) {
        if (n_in != 19 || in_sizes[0] != MROWS * DMODEL || out_size != MROWS * DMODEL || ws_size < WS_END) { fprintf(stderr, "kernel_launch: unexpected problem shape (n_in %d, in0 %d, out %d, ws %zu); nothing launched\n", n_in, n_in > 0 ? in_sizes[0] : -1, out_size, ws_size); grid = -1; return; }
        int dev = 0, cus = 0, per_cu = 0;
        if (hipGetDevice(&dev) != hipSuccess || hipDeviceGetAttribute(&cus, hipDeviceAttributeMultiprocessorCount, dev) != hipSuccess) { fprintf(stderr, "kernel_launch: device query failed\n"); grid = -1; return; }
        if (hipFuncSetAttribute((const void*)mk_fwd, hipFuncAttributeMaxDynamicSharedMemorySize, LDS_BYTES) != hipSuccess) { fprintf(stderr, "kernel_launch: hipFuncSetAttribute failed\n"); grid = -1; return; }
        if (hipOccupancyMaxActiveBlocksPerMultiprocessor(&per_cu, (const void*)mk_fwd, NWAVES * 64, LDS_BYTES) != hipSuccess || per_cu < 1) { fprintf(stderr, "kernel_launch: occupancy query gave %d\n", per_cu); per_cu = 1; }
        (void)hipGetLastError();
        grid = cus * per_cu;
    }
    if (grid < 0) return;
    Args a{};
    for (int i = 0; i < 19; ++i) a.in[i] = (const float*)d_in[i];
    a.out = (float*)d_out; a.ws = (unsigned char*)d_ws;
    void* kargs[] = {&a};
    const hipError_t e = hipLaunchCooperativeKernel((const void*)mk_fwd, dim3(grid), dim3(NWAVES * 64), kargs, LDS_BYTES, stream);
    if (e != hipSuccess) fprintf(stderr, "kernel_launch: cooperative launch failed: %s (grid %d)\n", hipGetErrorString(e), grid);
}
```

```cpp
#include <hip/hip_runtime.h>
#include <hip/hip_cooperative_groups.h>
#include <cstdio>
#include <cstdint>
namespace cg = cooperative_groups;
constexpr int NBATCH = 4, SEQLEN = 8192, DMODEL = 1024, MROWS = NBATCH * SEQLEN;
constexpr int GWIDTH = 2048, DFF = 2816;
constexpr float NORM_EPS = 1e-5f;
constexpr float LAM_INIT = 0.35550906759096934f;
constexpr float QSCALE = 0.125f * 1.4426950408889634f;
namespace pg8 {
#define PG8_LAS __attribute__((address_space(3)))
typedef unsigned short bf16_t;
typedef short bf16x8 __attribute__((ext_vector_type(8)));
typedef float f32x4 __attribute__((ext_vector_type(4)));
typedef unsigned u32x4 __attribute__((ext_vector_type(4)));
constexpr int BM = 256, BK = 64, HALF = 128, HTB = HALF * BK * 2  , STAGE_BYTES = 8 * HTB, NXCD = 8, WGM = 8;

__host__ __device__ __forceinline__ int lds_byte(int r, int c) { const int st = (r >> 4) * 2 + (c >> 5), rr = r & 15, cc = c & 31, ob = rr * 64 + cc * 2; return st * 1024 + (ob ^ (((ob >> 9) & 1) << 5)); }
__host__ __device__ __forceinline__ void stage_rc(int b, int& R, int& C) { const int st = b / 1024, sb = b % 1024, swz = sb ^ (((sb >> 9) & 1) << 5); R = (st >> 1) * 16 + swz / 64; C = (st & 1) * 32 + (swz % 64) / 2; }
__host__ __device__ __forceinline__ int perm32(int rho) { const int n = rho >> 4, i = rho & 15; return 8 * (i >> 2) + 4 * n + (i & 3); }

struct Unit { int pm, pn; };
struct Gemm { const bf16_t* A; const bf16_t* Bt; int M, N, K; };

struct StaticOrder {
    int nM, nN, nwg, G, c;
    __host__ __device__ void init(int M, int N, int G_, int c_) { nM = M / BM; nN = N / BM; nwg = nM * nN; G = G_; c = c_; }
    __host__ __device__ bool next(int i, Unit& u) const {
        const long L = (long)i * G + c; if (L >= nwg) return false;
        int wgid = (int)L; { const int q = nwg / NXCD, r = nwg % NXCD, xcd = wgid % NXCD, off = wgid / NXCD; wgid = (xcd < r ? xcd * (q + 1) : r * (q + 1) + (xcd - r) * q) + off; }
        const int nig = WGM * nN, gid = wgid / nig, fm = gid * WGM, gsz = (nM - fm) < WGM ? (nM - fm) : WGM;
        u.pm = fm + ((wgid % nig) % gsz); u.pn = (wgid % nig) / gsz; return true;
    }
    __device__ __forceinline__ void a_ready(const Unit&) const {}
    __device__ __forceinline__ void done(const Unit&) const {}
};

__device__ __forceinline__ unsigned cvt_pk_bf16(float lo, float hi) { unsigned r; asm volatile("v_cvt_pk_bf16_f32 %0, %1, %2" : "=v"(r) : "v"(lo), "v"(hi)); return r; }
typedef float f32x2 __attribute__((ext_vector_type(2)));
__device__ __forceinline__ f32x2 gelu_pk(f32x2 v) {
    const f32x2 av = __builtin_elementwise_abs(v), d = av * 0.2316418882f + 1.0f;
    f32x2 t; t.x = __builtin_amdgcn_rcpf(d.x); t.y = __builtin_amdgcn_rcpf(d.y);
    f32x2 q = t * 0.5307027145f + (-0.7265760135f); q = q * t + 0.7107068705f; q = q * t + (-0.142248368f); q = q * t + 0.127414796f; q = q * t;
    const f32x2 s = (v * v) * (-0.72134752044f);
    f32x2 e; e.x = __builtin_amdgcn_exp2f(s.x); e.y = __builtin_amdgcn_exp2f(s.y);
    const f32x2 m = v * (q * e), r = v - m;
    f32x2 o; o.x = v.x < 0.f ? m.x : r.x; o.y = v.y < 0.f ? m.y : r.y; return o;
}

template <int ACT  > struct EpiBf16 {
    static constexpr bool PERM = true, AFTER_DRAIN = false; static_assert(ACT == 0 || ACT == 1, "EpiBf16: ACT is 0 (none) or 1 (gelu_pk)");
    bf16_t* O; int ldc; const float* bias; int split_cols; size_t split_stride; float scale0;
    __device__ __forceinline__ void operator()(const f32x4 (&acc)[2][2][4][2], const Unit& u, int wr, int wc, int fr, int fq) const {
        const int row0 = u.pm * BM + wr * 64 + fr; int colt = u.pn * BM; bf16_t* base = O;
        float sc = 1.f; if (split_cols) { const int t = colt / split_cols; base += (size_t)t * split_stride; colt -= t * split_cols; if (t == 0) sc = scale0; }
        const int col0 = colt + wc * 32 + 8 * fq, bcol0 = u.pn * BM + wc * 32 + 8 * fq;
        f32x4 bv[2][2];
#pragma unroll
        for (int bj = 0; bj < 2; ++bj)
#pragma unroll
            for (int n = 0; n < 2; ++n) bv[bj][n] = bias ? *(const f32x4*)(bias + bcol0 + bj * HALF + 4 * n) : (f32x4){0.f, 0.f, 0.f, 0.f};
#pragma unroll
        for (int ai = 0; ai < 2; ++ai)
#pragma unroll
            for (int m = 0; m < 4; ++m) { bf16_t* rowp = base + (size_t)(row0 + ai * HALF + m * 16) * ldc + col0;
#pragma unroll
                for (int bj = 0; bj < 2; ++bj) { f32x4 v0 = acc[ai][bj][m][0] + bv[bj][0], v1 = acc[ai][bj][m][1] + bv[bj][1];
                    if (ACT == 1) { f32x2 a = gelu_pk((f32x2){v0[0], v0[1]}), b = gelu_pk((f32x2){v0[2], v0[3]}), c = gelu_pk((f32x2){v1[0], v1[1]}), d = gelu_pk((f32x2){v1[2], v1[3]});
                        v0 = (f32x4){a.x, a.y, b.x, b.y}; v1 = (f32x4){c.x, c.y, d.x, d.y}; }
                    v0 = v0 * sc; v1 = v1 * sc; u32x4 w; w.x = cvt_pk_bf16(v0[0], v0[1]); w.y = cvt_pk_bf16(v0[2], v0[3]); w.z = cvt_pk_bf16(v1[0], v1[1]); w.w = cvt_pk_bf16(v1[2], v1[3]);
                    *(u32x4*)(rowp + bj * HALF) = w; } }
    }
};
typedef float f32x2e __attribute__((ext_vector_type(2)));
__device__ __forceinline__ float bf_lo(unsigned w) { return __uint_as_float(w << 16); }
__device__ __forceinline__ float bf_hi(unsigned w) { return __uint_as_float(w & 0xffff0000u); }
struct EpiGeluUV {
    static constexpr bool PERM = true, AFTER_DRAIN = false;
    bf16_t* UV; float* lns;
    __device__ __forceinline__ void operator()(const f32x4 (&acc)[2][2][4][2], const Unit& u, int wr, int wc, int fr, int fq) const {
        const int isv = (u.pn >= 8) ? 1 : 0, pn = u.pn - 8 * isv;
        const int row0 = u.pm * BM + wr * 64 + fr, col0 = pn * BM + wc * 32 + 8 * fq;
        bf16_t* base = UV + (size_t)isv * ((size_t)MROWS * GWIDTH);
#pragma unroll
        for (int ai = 0; ai < 2; ++ai)
#pragma unroll
            for (int m = 0; m < 4; ++m) {
                const int row = row0 + ai * HALF + m * 16;
                bf16_t* rowp = base + (size_t)row * GWIDTH + col0;
                float s = 0.f, q = 0.f;
#pragma unroll
                for (int bj = 0; bj < 2; ++bj) {
                    const f32x4 v0 = acc[ai][bj][m][0], v1 = acc[ai][bj][m][1];
                    const f32x2 a = gelu_pk((f32x2){v0[0], v0[1]}), b = gelu_pk((f32x2){v0[2], v0[3]}), c = gelu_pk((f32x2){v1[0], v1[1]}), d = gelu_pk((f32x2){v1[2], v1[3]});
                    u32x4 w; w.x = cvt_pk_bf16(a.x, a.y); w.y = cvt_pk_bf16(b.x, b.y); w.z = cvt_pk_bf16(c.x, c.y); w.w = cvt_pk_bf16(d.x, d.y);
                    *(u32x4*)(rowp + bj * HALF) = w;
                    if (isv) {
                        const float e0 = a.x, e1 = a.y, e2 = b.x, e3 = b.y, e4 = c.x, e5 = c.y, e6 = d.x, e7 = d.y;
                        s += ((e0 + e1) + (e2 + e3)) + ((e4 + e5) + (e6 + e7));
                        q += ((e0 * e0 + e1 * e1) + (e2 * e2 + e3 * e3)) + ((e4 * e4 + e5 * e5) + (e6 * e6 + e7 * e7));
                    }
                }
                if (isv) {
                    s += __shfl_xor(s, 16); s += __shfl_xor(s, 32); q += __shfl_xor(q, 16); q += __shfl_xor(q, 32);
                    if (fq == 0) *(f32x2e*)(lns + (size_t)row * 64 + (pn * 4 + wc) * 2) = (f32x2e){s, q};
                }
            }
    }
};
template <bool BASE_F32, bool OUT_F32> struct EpiRes {
    static constexpr bool PERM = true, AFTER_DRAIN = false;
    const float* basef; const bf16_t* baseh; float* outf; bf16_t* outh; float* rms;
    __device__ __forceinline__ void operator()(const f32x4 (&acc)[2][2][4][2], const Unit& u, int wr, int wc, int fr, int fq) const {
        const int row0 = u.pm * BM + wr * 64 + fr, col0 = u.pn * BM + wc * 32 + 8 * fq;
        constexpr int MB = BASE_F32 ? 2 : 4;
#pragma unroll
        for (int g = 0; g < 8; g += MB) {
            f32x4 pf[MB][2][2]; u32x4 ph[MB][2];
#pragma unroll
            for (int k = 0; k < MB; ++k) { const int ai = (g + k) >> 2, m = (g + k) & 3; const size_t off = (size_t)(row0 + ai * HALF + m * 16) * DMODEL + col0;
#pragma unroll
                for (int bj = 0; bj < 2; ++bj) {
                    if (BASE_F32) { pf[k][bj][0] = *(const f32x4*)(basef + off + bj * HALF); pf[k][bj][1] = *(const f32x4*)(basef + off + bj * HALF + 4); }
                    else ph[k][bj] = *(const u32x4*)(baseh + off + bj * HALF); } }
            asm volatile("" ::: "memory");
#pragma unroll
            for (int k = 0; k < MB; ++k) {
                const int ai = (g + k) >> 2, m = (g + k) & 3;
                const int row = row0 + ai * HALF + m * 16; const size_t off = (size_t)row * DMODEL + col0;
                float q = 0.f;
#pragma unroll
                for (int bj = 0; bj < 2; ++bj) {
                    f32x4 b0, b1;
                    if (BASE_F32) { b0 = pf[k][bj][0]; b1 = pf[k][bj][1]; }
                    else { const u32x4 w = ph[k][bj]; b0 = (f32x4){bf_lo(w.x), bf_hi(w.x), bf_lo(w.y), bf_hi(w.y)}; b1 = (f32x4){bf_lo(w.z), bf_hi(w.z), bf_lo(w.w), bf_hi(w.w)}; }
                    const f32x4 o0 = b0 + acc[ai][bj][m][0], o1 = b1 + acc[ai][bj][m][1];
                    q += ((o0[0] * o0[0] + o0[1] * o0[1]) + (o0[2] * o0[2] + o0[3] * o0[3])) + ((o1[0] * o1[0] + o1[1] * o1[1]) + (o1[2] * o1[2] + o1[3] * o1[3]));
                    if (OUT_F32) { *(f32x4*)(outf + off + bj * HALF) = o0; *(f32x4*)(outf + off + bj * HALF + 4) = o1; }
                    else { u32x4 w; w.x = cvt_pk_bf16(o0[0], o0[1]); w.y = cvt_pk_bf16(o0[2], o0[3]); w.z = cvt_pk_bf16(o1[0], o1[1]); w.w = cvt_pk_bf16(o1[2], o1[3]); *(u32x4*)(outh + off + bj * HALF) = w; }
                }
                q += __shfl_xor(q, 16); q += __shfl_xor(q, 32);
                if (fq == 0) rms[(size_t)row * 16 + u.pn * 4 + wc] = q;
            }
            asm volatile("" ::: "memory");
        }
    }
};
__device__ __forceinline__ float row_rstd(const float* rms, int row) {
    const f32x4* rp = (const f32x4*)(rms + (size_t)row * 16);
    const f32x4 a = rp[0], b = rp[1], c = rp[2], d = rp[3];
    const float ss = ((a[0] + a[1]) + (a[2] + a[3])) + ((b[0] + b[1]) + (b[2] + b[3])) + ((c[0] + c[1]) + (c[2] + c[3])) + ((d[0] + d[1]) + (d[2] + d[3]));
    return 1.0f / sqrtf(ss * (1.0f / DMODEL) + NORM_EPS);
}
__device__ __forceinline__ float row_rstd_q(const float* rms, int row, int fq) {
    const f32x4 a = *(const f32x4*)(rms + (size_t)row * 16 + fq * 4);
    float ss = (a[0] + a[1]) + (a[2] + a[3]); ss += __shfl_xor(ss, 16); ss += __shfl_xor(ss, 32);
    return 1.0f / sqrtf(ss * (1.0f / DMODEL) + NORM_EPS);
}
struct EpiSwiglu {
    static constexpr bool PERM = true, AFTER_DRAIN = false;
    bf16_t* act; const float* rms;
    __device__ __forceinline__ void operator()(const f32x4 (&acc)[2][2][4][2], const Unit& u, int wr, int wc, int fr, int fq) const {
        const int row0 = u.pm * BM + wr * 64 + fr, col0 = u.pn * HALF + wc * 32 + 8 * fq;
        float rs_[2][4];
#pragma unroll
        for (int ai = 0; ai < 2; ++ai)
#pragma unroll
            for (int m = 0; m < 4; ++m) rs_[ai][m] = row_rstd_q(rms, row0 + ai * HALF + m * 16, fq);
#pragma unroll
        for (int ai = 0; ai < 2; ++ai)
#pragma unroll
            for (int m = 0; m < 4; ++m) {
                const int row = row0 + ai * HALF + m * 16; const float rstd = rs_[ai][m];
                float o[8];
#pragma unroll
                for (int n = 0; n < 2; ++n)
#pragma unroll
                    for (int e = 0; e < 4; ++e) { const float g = acc[ai][0][m][n][e] * rstd, up = acc[ai][1][m][n][e] * rstd;
                        const float sg = g * __builtin_amdgcn_rcpf(1.0f + __builtin_amdgcn_exp2f(-1.4426950408889634f * g)); o[n * 4 + e] = sg * up; }
                u32x4 w; w.x = cvt_pk_bf16(o[0], o[1]); w.y = cvt_pk_bf16(o[2], o[3]); w.z = cvt_pk_bf16(o[4], o[5]); w.w = cvt_pk_bf16(o[6], o[7]);
                *(u32x4*)(act + (size_t)row * DFF + col0) = w;
            }
    }
};
struct EpiKVQ {
    static constexpr bool PERM = true, AFTER_DRAIN = false;
    bf16_t* KVQ; const float* rms; const float* rope;
    __device__ __forceinline__ void operator()(const f32x4 (&acc)[2][2][4][2], const Unit& u, int wr, int wc, int fr, int fq) const {
        const int t = u.pn >> 2, colt = (u.pn & 3) * BM;
        const int row0 = u.pm * BM + wr * 64 + fr, col0 = colt + wc * 32 + 8 * fq;
        bf16_t* base = KVQ + (size_t)t * ((size_t)MROWS * DMODEL);
        const float sc = (t == 2) ? QSCALE : 1.0f;
        const bool roped = (t != 1) && ((wc & 1) == 0);
        float rs_[2][4];
#pragma unroll
        for (int ai = 0; ai < 2; ++ai)
#pragma unroll
            for (int m = 0; m < 4; ++m) rs_[ai][m] = row_rstd_q(rms, row0 + ai * HALF + m * 16, fq);
#pragma unroll
        for (int ai = 0; ai < 2; ++ai)
#pragma unroll
            for (int m = 0; m < 4; ++m) {
                const int row = row0 + ai * HALF + m * 16; const float rstd = rs_[ai][m];
                f32x4 c0 = {1.f, 1.f, 1.f, 1.f}, c1 = c0, s0 = {0.f, 0.f, 0.f, 0.f}, s1 = s0;
                if (roped && fq < 2) { const float* rp = rope + (size_t)(row & (SEQLEN - 1)) * 16;
                    c0 = *(const f32x4*)rp; c1 = *(const f32x4*)(rp + 4); s0 = *(const f32x4*)(rp + 8); s1 = *(const f32x4*)(rp + 12);
                    if (fq == 0) { s0 = -s0; s1 = -s1; } }
#pragma unroll
                for (int bj = 0; bj < 2; ++bj) {
                    f32x4 v0 = acc[ai][bj][m][0] * rstd, v1 = acc[ai][bj][m][1] * rstd;
                    if (roped) { f32x4 p0, p1;
#pragma unroll
                        for (int e = 0; e < 4; ++e) { p0[e] = __shfl_xor(v0[e], 16); p1[e] = __shfl_xor(v1[e], 16); }
                        v0 = v0 * c0 + p0 * s0; v1 = v1 * c1 + p1 * s1; }
                    v0 = v0 * sc; v1 = v1 * sc;
                    u32x4 w; w.x = cvt_pk_bf16(v0[0], v0[1]); w.y = cvt_pk_bf16(v0[2], v0[3]); w.z = cvt_pk_bf16(v1[0], v1[1]); w.w = cvt_pk_bf16(v1[2], v1[3]);
                    *(u32x4*)(base + (size_t)row * DMODEL + col0 + bj * HALF) = w;
                }
            }
    }
};

template <class Epi, class Sched, bool ALIGN_EPI = false, bool SP2 = false>
__device__ __forceinline__ void gemm_phase(PG8_LAS unsigned char* lds, const Gemm g, const Sched& S, const Epi& E) {
    int tid_ = threadIdx.x; asm volatile("" : "+v"(tid_));
    const int tid = tid_, wid = __builtin_amdgcn_readfirstlane(tid >> 6), lane = tid & 63, wr = wid >> 2, wc = wid & 3, fr = lane & 15, fq = lane >> 4;
    const int K = g.K, nt = K / BK;
    unsigned voffA[2], voffB[2];
#pragma unroll
    for (int i = 0; i < 2; ++i) { int R, C; stage_rc(tid * 16 + i * 8192, R, C); const int Rb = Epi::PERM ? ((R & ~31) + perm32(R & 31)) : R;
        voffA[i] = (unsigned)(R * K + C) * 2u; voffB[i] = (unsigned)(Rb * K + C) * 2u; }
    const size_t kstep = (size_t)(BK * 2);
    const size_t hstep = (size_t)HALF * K * 2;
    const size_t tstep = 2 * hstep;
    const unsigned ldsw = (unsigned)wid * 1024u;
    const int aoff = lds_byte(wr * 64 + fr, fq * 8), boff = lds_byte(wc * 32 + fr, fq * 8);
#define PG8_SA(b, h) (((b) * 2 + (h)) * HTB)
#define PG8_SB(b, h) ((4 + (b) * 2 + (h)) * HTB)
#define PG8_STAGE(bufoff, gbase, voff) do { _Pragma("unroll") for (int _i = 0; _i < 2; ++_i) \
        __builtin_amdgcn_global_load_lds((const unsigned*)((const char*)(gbase) + (voff)[_i]), (PG8_LAS unsigned*)(lds + (bufoff) + ldsw + _i * 8192), 16, 0, 0); } while (0)
#define PG8_LDA(dst, b, h) do { _Pragma("unroll") for (int m = 0; m < 4; ++m) _Pragma("unroll") for (int k = 0; k < 2; ++k) dst[m][k] = *(const PG8_LAS bf16x8*)(lds + PG8_SA(b, h) + aoff + m * 2048 + k * 1024); } while (0)
#define PG8_LDB(dst, b, h) do { _Pragma("unroll") for (int n = 0; n < 2; ++n) _Pragma("unroll") for (int k = 0; k < 2; ++k) dst[n][k] = *(const PG8_LAS bf16x8*)(lds + PG8_SB(b, h) + boff + n * 2048 + k * 1024); } while (0)
#define PG8_MMA(ai, bj, At, Bt) do { __builtin_amdgcn_s_setprio(1); _Pragma("unroll") for (int m = 0; m < 4; ++m) _Pragma("unroll") for (int n = 0; n < 2; ++n) _Pragma("unroll") for (int k = 0; k < 2; ++k) \
        acc[ai][bj][m][n] = __builtin_amdgcn_mfma_f32_16x16x32_bf16(Bt[n][k], At[m][k], acc[ai][bj][m][n], 0, 0, 0); __builtin_amdgcn_s_setprio(0); } while (0)
#define PG8_WAIT_V(n) asm volatile("s_waitcnt vmcnt(" #n ")" ::: "memory")
#define PG8_WAIT_L(n) asm volatile("s_waitcnt lgkmcnt(" #n ")" ::: "memory")
#define PG8_BAR __builtin_amdgcn_s_barrier()
#define PG8_SCHED __builtin_amdgcn_sched_barrier(0)
    Unit cur, nxt; int ui = 0;
    if (!S.next(0, cur)) return;
    f32x4 acc[2][2][4][2];
#pragma unroll
    for (int a = 0; a < 2; ++a)
#pragma unroll
        for (int b = 0; b < 2; ++b)
#pragma unroll
            for (int m = 0; m < 4; ++m)
#pragma unroll
                for (int n = 0; n < 2; ++n) acc[a][b][m][n] = (f32x4){0.f, 0.f, 0.f, 0.f};
    bf16x8 At[4][2], B0[2][2], B1[2][2];
    const char* cA = (const char*)g.A + (size_t)cur.pm * tstep; const char* cB = (const char*)g.Bt + (size_t)cur.pn * tstep;
    S.a_ready(cur);
    if constexpr (SP2) {
        PG8_STAGE(PG8_SB(0, 0), cB, voffB); PG8_STAGE(PG8_SB(0, 1), cB + hstep, voffB); PG8_STAGE(PG8_SA(0, 0), cA, voffA); PG8_STAGE(PG8_SA(0, 1), cA + hstep, voffA);
        if (wr == 1) PG8_BAR;
        PG8_WAIT_V(2); PG8_BAR;
        PG8_STAGE(PG8_SB(1, 0), cB + kstep, voffB); PG8_STAGE(PG8_SA(1, 0), cA + kstep, voffA); PG8_STAGE(PG8_SB(1, 1), cB + hstep + kstep, voffB);
        PG8_WAIT_V(6); PG8_BAR;
    } else {
        PG8_STAGE(PG8_SB(0, 0), cB, voffB); PG8_STAGE(PG8_SA(0, 0), cA, voffA); PG8_STAGE(PG8_SB(0, 1), cB + hstep, voffB); PG8_STAGE(PG8_SA(0, 1), cA + hstep, voffA);
        if (wr == 1) PG8_BAR;
        PG8_WAIT_V(4); PG8_BAR;
        PG8_STAGE(PG8_SB(1, 0), cB + kstep, voffB); PG8_STAGE(PG8_SA(1, 0), cA + kstep, voffA); PG8_STAGE(PG8_SB(1, 1), cB + hstep + kstep, voffB);
        PG8_WAIT_V(6); PG8_BAR;
    }
    for (;;) {
        const bool has_next = S.next(ui + 1, nxt);
        const char* nA = has_next ? (const char*)g.A + (size_t)nxt.pm * tstep : cA; const char* nB = has_next ? (const char*)g.Bt + (size_t)nxt.pn * tstep : cB;
        for (int t = 0; t < nt; t += 2) {
            const bool last = (t == nt - 2);
            const char* a1 = cA + (size_t)(t + 1) * kstep;
            const char* a2 = last ? nA : cA + (size_t)(t + 2) * kstep; const char* b2 = last ? nB : cB + (size_t)(t + 2) * kstep;
            const char* a3 = a2 + kstep; const char* b3 = b2 + kstep;
            if (last && has_next) S.a_ready(nxt);
            if constexpr (SP2) {
            PG8_LDB(B0, 0, 0); PG8_LDB(B1, 0, 1); PG8_SCHED; PG8_LDA(At, 0, 0); PG8_STAGE(PG8_SA(1, 1), a1 + hstep, voffA);
            PG8_WAIT_V(8); PG8_WAIT_L(0); PG8_BAR; PG8_MMA(0, 0, At, B0); PG8_MMA(0, 1, At, B1); PG8_BAR; PG8_SCHED;
            PG8_LDA(At, 0, 1); PG8_STAGE(PG8_SB(0, 0), b2, voffB); PG8_STAGE(PG8_SB(0, 1), b2 + hstep, voffB); PG8_STAGE(PG8_SA(0, 0), a2, voffA);
            PG8_WAIT_V(8); PG8_WAIT_L(0); PG8_BAR; PG8_MMA(1, 0, At, B0); PG8_MMA(1, 1, At, B1); PG8_BAR; PG8_SCHED;
            PG8_LDB(B0, 1, 0); PG8_LDB(B1, 1, 1); PG8_SCHED; PG8_LDA(At, 1, 0); PG8_STAGE(PG8_SA(0, 1), a2 + hstep, voffA);
            PG8_WAIT_V(8); PG8_WAIT_L(0); PG8_BAR; PG8_MMA(0, 0, At, B0); PG8_MMA(0, 1, At, B1); PG8_BAR; PG8_SCHED;
            PG8_LDA(At, 1, 1); PG8_STAGE(PG8_SB(1, 0), b3, voffB); PG8_STAGE(PG8_SB(1, 1), b3 + hstep, voffB); PG8_STAGE(PG8_SA(1, 0), a3, voffA);
            PG8_WAIT_V(8); PG8_WAIT_L(0); PG8_BAR; PG8_MMA(1, 0, At, B0); PG8_MMA(1, 1, At, B1); PG8_BAR; PG8_SCHED;
            } else {
            PG8_LDB(B0, 0, 0); PG8_SCHED; PG8_LDA(At, 0, 0); PG8_STAGE(PG8_SA(1, 1), a1 + hstep, voffA);
            PG8_WAIT_L(8); PG8_BAR; PG8_WAIT_L(0); PG8_MMA(0, 0, At, B0); PG8_BAR; PG8_SCHED;
            PG8_LDB(B1, 0, 1); PG8_STAGE(PG8_SB(0, 0), b2, voffB);
            PG8_BAR; PG8_WAIT_L(0); PG8_MMA(0, 1, At, B1); PG8_BAR;
            PG8_LDA(At, 0, 1); PG8_STAGE(PG8_SA(0, 0), a2, voffA);
            PG8_BAR; PG8_WAIT_L(0); PG8_MMA(1, 0, At, B0); PG8_BAR; PG8_SCHED;
            PG8_STAGE(PG8_SB(0, 1), b2 + hstep, voffB);
            PG8_WAIT_V(6); PG8_BAR; PG8_MMA(1, 1, At, B1); PG8_BAR;
            PG8_LDB(B0, 1, 0); PG8_SCHED; PG8_LDA(At, 1, 0); PG8_STAGE(PG8_SA(0, 1), a2 + hstep, voffA);
            PG8_WAIT_L(8); PG8_BAR; PG8_WAIT_L(0); PG8_MMA(0, 0, At, B0); PG8_BAR; PG8_SCHED;
            PG8_LDB(B1, 1, 1); PG8_STAGE(PG8_SB(1, 0), b3, voffB);
            PG8_BAR; PG8_WAIT_L(0); PG8_MMA(0, 1, At, B1); PG8_BAR;
            PG8_LDA(At, 1, 1); PG8_STAGE(PG8_SA(1, 0), a3, voffA);
            PG8_BAR; PG8_WAIT_L(0); PG8_MMA(1, 0, At, B0); PG8_BAR; PG8_SCHED;
            PG8_STAGE(PG8_SB(1, 1), b3 + hstep, voffB);
            PG8_WAIT_V(6); PG8_BAR; PG8_MMA(1, 1, At, B1); PG8_BAR;
            }
        }
        if constexpr (ALIGN_EPI) { if (wr == 0) PG8_BAR; }
        if constexpr (!Epi::AFTER_DRAIN) { E(acc, cur, wr, wc, fr, fq); S.done(cur); }
        if (!has_next) break;
#pragma unroll
        for (int a = 0; a < 2; ++a)
#pragma unroll
            for (int b = 0; b < 2; ++b)
#pragma unroll
                for (int m = 0; m < 4; ++m)
#pragma unroll
                    for (int n = 0; n < 2; ++n) acc[a][b][m][n] = (f32x4){0.f, 0.f, 0.f, 0.f};
        cur = nxt; cA = nA; cB = nB; ++ui;
        if constexpr (ALIGN_EPI) { if (wr == 1) PG8_BAR; }
    }
    PG8_WAIT_V(0);
    if constexpr (!ALIGN_EPI) { if (wr == 0) PG8_BAR; }
    PG8_BAR;
    if constexpr (Epi::AFTER_DRAIN) { E.fused(acc, cur, wr, wc, fr, fq, lds, wid, lane); S.done(cur); }
#undef PG8_SA
#undef PG8_SB
#undef PG8_STAGE
#undef PG8_LDA
#undef PG8_LDB
#undef PG8_MMA
#undef PG8_WAIT_V
#undef PG8_WAIT_L
#undef PG8_BAR
#undef PG8_SCHED
}
}
#include <hip/hip_bf16.h>
#include <cmath>
namespace attn_body {
using bf16=__hip_bfloat16;
using bf16x8=__attribute__((ext_vector_type(8)))short;
using s16x4=__attribute__((ext_vector_type(4)))short;
using f32x16=__attribute__((ext_vector_type(16)))float;
using u32x4=__attribute__((ext_vector_type(4)))unsigned;
constexpr int BATCH=4,NHEAD=16,SEQ=8192,D=64,DM=1024;
constexpr int NW=8,QBLK=32,QB=QBLK*NW,KVBLK=64,NQB=SEQ/QB;
constexpr int ATTN_PITCH=DM, ATTN_UNIT_ROWS=QB;
__device__ __forceinline__ int crow(int r,int hi){return (r&3)+8*(r>>2)+4*hi;}
#define SBAR() __builtin_amdgcn_sched_barrier(0)
__device__ __forceinline__ void cmask(f32x16&p0,f32x16&p1,int jb,int qrel,int hi){
  const float NEG=-INFINITY; int kb=64*jb+4*hi;
  #pragma unroll
  for(int r=0;r<16;++r){int kv=kb+(r&3)+8*(r>>2); if(kv>qrel)p0[r]=NEG; if(kv+32>qrel)p1[r]=NEG;}
}

constexpr int NSLOT=3, SLOTB=8192;
constexpr int LDS_K=0, LDS_V=NSLOT*SLOTB, LDS_WS=2*NSLOT*SLOTB, LDS_OST=LDS_WS+NW*64*4, LDS_BYTES=LDS_OST+NW*4096;
constexpr float C2=0.125f*1.4426950408889634f;
__device__ __forceinline__ void glds16(const void*gsrc,unsigned lds_dst){unsigned keep;
  asm volatile("s_mov_b32 %0, m0\n\ts_mov_b32 m0, %2\n\ts_nop 0\n\tglobal_load_lds_dwordx4 %1, off\n\ts_mov_b32 m0, %0":"=&s"(keep):"v"(gsrc),"s"(lds_dst):"memory");}
__device__ __forceinline__ float max3f(float a,float b,float c){float r;asm("v_max3_f32 %0, %1, %2, %3":"=v"(r):"v"(a),"v"(b),"v"(c));return r;}
__device__ __forceinline__ float max2f(float a,float b){float r;asm("v_max_f32_e32 %0, %1, %2":"=v"(r):"v"(a),"v"(b));return r;}
__device__ __forceinline__ float fadd_s(float a,float b){float r;asm("v_add_f32_e32 %0, %1, %2":"=v"(r):"v"(a),"v"(b));return r;}
__device__ __forceinline__ float fsub_s(float a,float b){float r;asm("v_sub_f32_e32 %0, %1, %2":"=v"(r):"v"(a),"v"(b));return r;}
typedef float f32x2_t __attribute__((ext_vector_type(2))); typedef __bf16 bf16x2_t __attribute__((ext_vector_type(2)));
__device__ __forceinline__ unsigned cvtpk_s(float lo,float hi){f32x2_t v={lo,hi};bf16x2_t b=__builtin_convertvector(v,bf16x2_t);return __builtin_bit_cast(unsigned,b);}
#define WAIT_BAR(N) asm volatile("s_waitcnt vmcnt(" #N ") lgkmcnt(0)\n\ts_barrier":::"memory")

__device__ __forceinline__ void qkt(f32x16&p0,f32x16&p1,const char*Kslot,const bf16x8*qr,const f32x16&negm,int r32,int hi){
  const char*kb=Kslot+hi*1024+r32*16;
  #pragma unroll
  for(int d0=0;d0<4;++d0){
    const bf16x8 b0=*reinterpret_cast<const bf16x8*>(kb+d0*2048);
    const bf16x8 b1=*reinterpret_cast<const bf16x8*>(kb+d0*2048+512);
    if(d0==0){p0=__builtin_amdgcn_mfma_f32_32x32x16_bf16(b0,qr[0],negm,0,0,0);p1=__builtin_amdgcn_mfma_f32_32x32x16_bf16(b1,qr[0],negm,0,0,0);}
    else{p0=__builtin_amdgcn_mfma_f32_32x32x16_bf16(b0,qr[d0],p0,0,0,0);p1=__builtin_amdgcn_mfma_f32_32x32x16_bf16(b1,qr[d0],p1,0,0,0);}}
}
typedef __attribute__((address_space(3))) const char* lds_cptr;
typedef short v4i16_t __attribute__((ext_vector_type(4)));
__device__ __forceinline__ void kload8(bf16x8*kf,lds_cptr kp){
  kf[0]=*(const __attribute__((address_space(3))) bf16x8*)(kp);      kf[1]=*(const __attribute__((address_space(3))) bf16x8*)(kp+512);
  kf[2]=*(const __attribute__((address_space(3))) bf16x8*)(kp+2048); kf[3]=*(const __attribute__((address_space(3))) bf16x8*)(kp+2560);
  kf[4]=*(const __attribute__((address_space(3))) bf16x8*)(kp+4096); kf[5]=*(const __attribute__((address_space(3))) bf16x8*)(kp+4608);
  kf[6]=*(const __attribute__((address_space(3))) bf16x8*)(kp+6144); kf[7]=*(const __attribute__((address_space(3))) bf16x8*)(kp+6656);
}
__device__ __forceinline__ void kload2(bf16x8*kf,lds_cptr kp,int j){ kf[2*j]=*(const __attribute__((address_space(3))) bf16x8*)(kp+j*2048); kf[2*j+1]=*(const __attribute__((address_space(3))) bf16x8*)(kp+j*2048+512); }
__device__ __forceinline__ s16x4 vtr(lds_cptr p){ return __builtin_bit_cast(s16x4,__builtin_amdgcn_ds_read_tr16_b64_v4i16((__attribute__((address_space(3))) v4i16_t*)p)); }
__device__ __forceinline__ float rowmax(const f32x16&p0,const f32x16&p1){
  float a=max3f(p0[0],p0[1],p1[0]),b=max3f(p0[2],p0[3],p1[1]);a=max3f(a,p1[2],p1[3]);
  #pragma unroll
  for(int r=4;r<16;r+=4){a=max3f(a,p0[r],p0[r+1]);b=max3f(b,p0[r+2],p0[r+3]);a=max3f(a,p1[r],p1[r+1]);b=max3f(b,p1[r+2],p1[r+3]);}
  const float m=max2f(a,b);
  auto rr=__builtin_amdgcn_permlane32_swap(__float_as_uint(m),__float_as_uint(m),false,false);
  return max2f(__uint_as_float(rr[0]),__uint_as_float(rr[1]));
}
__device__ __forceinline__ void pv(f32x16*o,int vb,bf16x8 pa0,bf16x8 pa1,bf16x8 pa2,bf16x8 pa3){
  #pragma unroll
  for(int d0=0;d0<2;++d0){s16x4 lo[4],hi[4];
    #pragma unroll
    for(int ks=0;ks<4;++ks){
      asm volatile("ds_read_b64_tr_b16 %0,%1 offset:%c2":"=&v"(lo[ks]):"v"(vb),"i"(d0*4096+ks*1024):"memory");
      asm volatile("ds_read_b64_tr_b16 %0,%1 offset:%c2":"=&v"(hi[ks]):"v"(vb),"i"(d0*4096+ks*1024+512):"memory");}
    asm volatile("s_waitcnt lgkmcnt(0)":::"memory");SBAR();
    #define PK(k) (bf16x8){lo[k][0],lo[k][1],lo[k][2],lo[k][3],hi[k][0],hi[k][1],hi[k][2],hi[k][3]}
    o[d0]=__builtin_amdgcn_mfma_f32_32x32x16_bf16(pa0,PK(0),o[d0],0,0,0);
    o[d0]=__builtin_amdgcn_mfma_f32_32x32x16_bf16(pa1,PK(1),o[d0],0,0,0);
    o[d0]=__builtin_amdgcn_mfma_f32_32x32x16_bf16(pa2,PK(2),o[d0],0,0,0);
    o[d0]=__builtin_amdgcn_mfma_f32_32x32x16_bf16(pa3,PK(3),o[d0],0,0,0);
    #undef PK
  }
}

#ifndef ATTN_STORE16
#define ATTN_STORE16(p,v) (*(u32x4*)(p)=(v))
#endif
template<int THRL> __device__ __forceinline__ void attn_unit(int b,int qcol,int kcol,int vcol,int ocol,int qb,const bf16*Q,const bf16*__restrict__ K,const bf16*__restrict__ V,bf16*O,char*shm){
  const int tid=threadIdx.x,lane=tid&63,r32=lane&31,hi=lane>>5; const int wid=__builtin_amdgcn_readfirstlane(tid>>6);
  const long rowbase=(long)b*SEQ; const int q0=qb*QB;
  const bf16*Qw=Q+(rowbase+q0+wid*QBLK)*DM+qcol;
  const bf16*Kh=K+rowbase*DM+kcol,*Vh=V+rowbase*DM+vcol;
  const unsigned lds0=(unsigned)(uintptr_t)shm;
  float*wsf=(float*)(shm+LDS_WS)+wid*64;
  const bf16*ksrc=Kh+(long)lane*DM+wid*8;
  const bf16*vsrc=Vh+(long)(16*(wid&3)+(lane>>2))*DM+(wid>>2)*32+(lane&3)*8;
  const unsigned kdst=lds0+LDS_K+wid*1024, vdst=lds0+LDS_V+wid*1024;
  #define DMA_K(t,slot) glds16(ksrc+(long)(t)*KVBLK*DM,(unsigned)__builtin_amdgcn_readfirstlane(kdst+(slot)))
  #define DMA_V(t,slot) glds16(vsrc+(long)(t)*KVBLK*DM,(unsigned)__builtin_amdgcn_readfirstlane(vdst+(slot)))
  const int vb0=(int)(lds0+LDS_V)+((lane>>4)&1)*32+(lane&3)*8+(4*hi+((lane&15)>>2))*64;
  const char*Kbase=shm+LDS_K; bf16x8 kf[8];
  const lds_cptr shm3=(lds_cptr)shm; const lds_cptr kp0=shm3+LDS_K+hi*1024+r32*16; const lds_cptr vp0=shm3+LDS_V+((lane>>4)&1)*32+(lane&3)*8+(4*hi+((lane&15)>>2))*64;
  const int NT=(q0+QB)/KVBLK;
  DMA_K(0,0);DMA_V(0,0);DMA_K(1,SLOTB);
  bf16x8 qr[4];
  #pragma unroll
  for(int d0=0;d0<4;++d0)qr[d0]=*reinterpret_cast<const bf16x8*>(&Qw[(long)r32*DM+d0*16+hi*8]);
  float mhat=0.f,l_reg=0.f;f32x16 o[2];o[0]=f32x16{};o[1]=f32x16{};f32x16 negm=f32x16{};asm volatile("":"+v"(negm));
  const int qrel=wid*QBLK+r32;
  #define CMASK(P0,P1,t) do{int jb_=(t)-(NT-4); if(jb_>=0)cmask(P0,P1,jb_,qrel,hi);}while(0)
  bool resc=false;
  #define START(P0,P1) do{ const float rm=rowmax(P0,P1); resc=false; \
    { const float dl=rm; mhat=fadd_s(mhat,dl); \
      _Pragma("unroll") for(int r=0;r<16;++r){P0[r]=fsub_s(P0[r],dl);P1[r]=fsub_s(P1[r],dl);} \
      _Pragma("unroll") for(int r=0;r<16;++r)negm[r]=-mhat; asm volatile("":"+v"(negm)); } \
    _Pragma("unroll") for(int r=0;r<16;++r)P0[r]=__builtin_amdgcn_exp2f(P0[r]); }while(0)
  #define RESC() do{ if(resc){ asm volatile("s_waitcnt lgkmcnt(0)":::"memory"); \
      _Pragma("unroll") for(int d_=0;d_<2;++d_) _Pragma("unroll") for(int r=0;r<16;++r)o[d_][r]*=wsf[crow(r,hi)]; } }while(0)
  f32x16 pA0,pA1,pB0,pB1;
  int sl_prev=0,sl_cur=0,sl_next=SLOTB;
  #define ROT() do{sl_prev=sl_cur;sl_cur=sl_next;sl_next=(sl_next==(NSLOT-1)*SLOTB)?0:sl_next+SLOTB;}while(0)
  DMA_K(2,2*SLOTB);
  WAIT_BAR(3);
  qkt(pA0,pA1,Kbase,qr,negm,r32,hi);asm volatile("s_nop 15\n\ts_nop 7":"+v"(pA0),"+v"(pA1));CMASK(pA0,pA1,0);
  START(pA0,pA1);
  _Pragma("unroll") for(int r=0;r<16;++r)pA1[r]=__builtin_amdgcn_exp2f(pA1[r]);
  WAIT_BAR(0);
  DMA_K(3,0);DMA_V(1,SLOTB);
  ROT();
  kload8(kf,kp0+sl_cur);
  WAIT_BAR(2);
  s16x4 vlo[8],vhi[8]; u32x4 pw0,pw1,pw2,pw3;
  #define PKW(P,B) cvtpk_s(P[B],P[B+1])
  #define PAF(k) __builtin_bit_cast(bf16x8,pw##k)
  #define VFR(i) (bf16x8){vlo[i][0],vlo[i][1],vlo[i][2],vlo[i][3],vhi[i][0],vhi[i][1],vhi[i][2],vhi[i][3]}
  #define PIN(x) asm volatile("":"+v"(x))
  #define MX3(a,b,c) __builtin_fmaxf(__builtin_fmaxf((a),(b)),(c))
  #define GAPA(MF,A0,A1,A2,A3,W0,W1,PW) do{ MF; sacc+=A0; sacc+=A1; sacc+=A2; sacc+=A3; PIN(sacc); W0; W1; PIN(PW); SBAR(); }while(0)
  #define EX(v) __builtin_amdgcn_exp2f(v)
  #define GAPB(MF,X,B) do{ MF; X[B]=EX(X[B]); X[B+1]=EX(X[B+1]); X[B+2]=EX(X[B+2]); X[B+3]=EX(X[B+3]); PIN(X); SBAR(); }while(0)
  #define VRD(i) do{ vlo[i]=vtr(vp_+(((i)>>2)*4096+((i)&3)*1024)); vhi[i]=vtr(vp_+(((i)>>2)*4096+((i)&3)*1024+512)); }while(0)
  #define KRD(G,j) do{ if(G){ kload2(kf,kp0+sl_next,j); SBAR(); } }while(0)
  #define STEP(C0,C1,P0,P1,t,GK,GV,GL) do{ SBAR(); \
    const lds_cptr vp_=vp0+sl_prev; \
    VRD(0); SBAR(); float sacc=(P0[0]+P0[1]); \
    GAPA(C0=__builtin_amdgcn_mfma_f32_32x32x16_bf16(kf[0],qr[0],negm,0,0,0), P0[2],P0[3],P0[4],P0[5],     pw0[0]=PKW(P0,0), pw0[1]=PKW(P0,2), pw0); \
    VRD(4); SBAR(); GAPA(C1=__builtin_amdgcn_mfma_f32_32x32x16_bf16(kf[1],qr[0],negm,0,0,0), P0[6],P0[7],P0[8],P0[9],     pw0[2]=PKW(P0,4), pw0[3]=PKW(P0,6), pw0); \
    VRD(1); SBAR(); GAPA(C0=__builtin_amdgcn_mfma_f32_32x32x16_bf16(kf[2],qr[1],C0,0,0,0),   P0[10],P0[11],P0[12],P0[13], pw1[0]=PKW(P0,8), pw1[1]=PKW(P0,10), pw1); \
    VRD(5); SBAR(); GAPA(C1=__builtin_amdgcn_mfma_f32_32x32x16_bf16(kf[3],qr[1],C1,0,0,0),   P0[14],P0[15],P1[0],P1[1],   pw1[2]=PKW(P0,12),pw1[3]=PKW(P0,14), pw1); \
    VRD(2); SBAR(); GAPA(C0=__builtin_amdgcn_mfma_f32_32x32x16_bf16(kf[4],qr[2],C0,0,0,0),   P1[2],P1[3],P1[4],P1[5],     pw2[0]=PKW(P1,0), pw2[1]=PKW(P1,2), pw2); \
    VRD(6); SBAR(); GAPA(C1=__builtin_amdgcn_mfma_f32_32x32x16_bf16(kf[5],qr[2],C1,0,0,0),   P1[6],P1[7],P1[8],P1[9],     pw2[2]=PKW(P1,4), pw2[3]=PKW(P1,6), pw2); \
    VRD(3); SBAR(); GAPA(C0=__builtin_amdgcn_mfma_f32_32x32x16_bf16(kf[6],qr[3],C0,0,0,0),   P1[10],P1[11],P1[12],P1[13], pw3[0]=PKW(P1,8), pw3[1]=PKW(P1,10), pw3); \
    VRD(7); SBAR(); GAPA(C1=__builtin_amdgcn_mfma_f32_32x32x16_bf16(kf[7],qr[3],C1,0,0,0),   P1[14],P1[15],0.f,0.f,       pw3[2]=PKW(P1,12),pw3[3]=PKW(P1,14), pw3); \
    l_reg+=sacc; \
    if(GK){DMA_K((t)+3,sl_cur);} if(GV){DMA_V((t)+1,sl_next);} \
    CMASK(C0,C1,t); \
    { float a=MX3(C0[0],C0[1],C1[0]),b=MX3(C0[2],C0[3],C1[1]); a=MX3(a,C1[2],C1[3]); \
      _Pragma("unroll") for(int r=4;r<16;r+=4){a=MX3(a,C0[r],C0[r+1]);b=MX3(b,C0[r+2],C0[r+3]);a=MX3(a,C1[r],C1[r+1]);b=MX3(b,C1[r+2],C1[r+3]);} \
      float rm=__builtin_fmaxf(a,b); { auto rr=__builtin_amdgcn_permlane32_swap(__float_as_uint(rm),__float_as_uint(rm),false,false); rm=__builtin_fmaxf(__uint_as_float(rr[0]),__uint_as_float(rr[1])); } \
      resc=false; \
      if(__builtin_expect(__any(rm>(float)THRL),0)){ const float dl=__builtin_fmaxf(rm,0.f); mhat+=dl; \
        _Pragma("unroll") for(int r=0;r<16;++r){C0[r]-=dl;C1[r]-=dl;} \
        _Pragma("unroll") for(int r=0;r<16;++r)negm[r]=-mhat; asm volatile("":"+v"(negm)); \
        const float f=__builtin_amdgcn_exp2f(-dl); l_reg*=f; if(hi==0)wsf[r32]=f; resc=true; } } \
    SBAR(); \
    GAPB(o[0]=__builtin_amdgcn_mfma_f32_32x32x16_bf16(PAF(0),VFR(0),o[0],0,0,0), C0,0); \
    GAPB(o[1]=__builtin_amdgcn_mfma_f32_32x32x16_bf16(PAF(0),VFR(4),o[1],0,0,0), C0,4); \
    KRD(GL,0); GAPB(o[0]=__builtin_amdgcn_mfma_f32_32x32x16_bf16(PAF(1),VFR(1),o[0],0,0,0), C0,8); \
    KRD(GL,1); GAPB(o[1]=__builtin_amdgcn_mfma_f32_32x32x16_bf16(PAF(1),VFR(5),o[1],0,0,0), C0,12); \
    KRD(GL,2); GAPB(o[0]=__builtin_amdgcn_mfma_f32_32x32x16_bf16(PAF(2),VFR(2),o[0],0,0,0), C1,0); \
    KRD(GL,3); GAPB(o[1]=__builtin_amdgcn_mfma_f32_32x32x16_bf16(PAF(2),VFR(6),o[1],0,0,0), C1,4); \
    GAPB(o[0]=__builtin_amdgcn_mfma_f32_32x32x16_bf16(PAF(3),VFR(3),o[0],0,0,0), C1,8); \
    GAPB(o[1]=__builtin_amdgcn_mfma_f32_32x32x16_bf16(PAF(3),VFR(7),o[1],0,0,0), C1,12); \
    }while(0)
  int t=1;
  #undef CMASK
  #define CMASK(P0,P1,t) do{}while(0)
  for(;t+5<NT;t+=2){
    STEP(pB0,pB1,pA0,pA1,t,true,true,true);     WAIT_BAR(2); RESC(); ROT();
    STEP(pA0,pA1,pB0,pB1,t+1,true,true,true);   WAIT_BAR(2); RESC(); ROT();
  }
  #undef CMASK
  #define CMASK(P0,P1,t) do{int jb_=(t)-(NT-4); if(jb_>=0)cmask(P0,P1,jb_,qrel,hi);}while(0)
  #define ENDW(tt) do{ if((tt)+3<NT){WAIT_BAR(2);} else if((tt)+2<NT){WAIT_BAR(1);} else {WAIT_BAR(0);} }while(0)
  for(;t+1<NT;t+=2){
    STEP(pB0,pB1,pA0,pA1,t,(t+3<NT),(t+1<NT),(t+1<NT));       ENDW(t);   RESC(); ROT();
    STEP(pA0,pA1,pB0,pB1,t+1,(t+4<NT),(t+2<NT),(t+2<NT));     ENDW(t+1); RESC(); ROT();
  }
  STEP(pB0,pB1,pA0,pA1,NT-1,false,false,false); RESC();
  { float sacc=pB0[0]+pB0[1]; _Pragma("unroll") for(int r=2;r<16;++r)sacc+=pB0[r]; _Pragma("unroll") for(int r=0;r<16;++r)sacc+=pB1[r]; l_reg+=sacc;
    pw0=(u32x4){PKW(pB0,0),PKW(pB0,2),PKW(pB0,4),PKW(pB0,6)};pw1=(u32x4){PKW(pB0,8),PKW(pB0,10),PKW(pB0,12),PKW(pB0,14)};pw2=(u32x4){PKW(pB1,0),PKW(pB1,2),PKW(pB1,4),PKW(pB1,6)};pw3=(u32x4){PKW(pB1,8),PKW(pB1,10),PKW(pB1,12),PKW(pB1,14)};
    SBAR(); pv(o,vb0+sl_cur,PAF(0),PAF(1),PAF(2),PAF(3)); }
  #undef PKW
  #undef PAF
  #undef VFR
  #undef PIN
  #undef MX3
  #undef GAPA
  #undef GAPB
  #undef EX
  #undef VRD
  #undef KRD
  #undef STEP
  #undef ENDW
  {auto rr=__builtin_amdgcn_permlane32_swap(__float_as_uint(l_reg),__float_as_uint(l_reg),false,false);l_reg=__uint_as_float(rr[0])+__uint_as_float(rr[1]);}
  if(hi==0)wsf[32+r32]=l_reg;asm volatile("s_waitcnt lgkmcnt(0)":::"memory");
  float rli[16];
  #pragma unroll
  for(int r=0;r<16;++r)rli[r]=__builtin_amdgcn_rcpf(wsf[32+crow(r,hi)]);
  bf16*Ow=O+(rowbase+q0+wid*QBLK)*DM+ocol;
  { bf16*stg=(bf16*)(shm+LDS_OST)+wid*2048;
    #pragma unroll
    for(int r=0;r<16;++r){const int orow=crow(r,hi);
      #pragma unroll
      for(int d0=0;d0<2;++d0)stg[orow*64+d0*32+r32]=__float2bfloat16(o[d0][r]*rli[r]);}
    asm volatile("s_waitcnt lgkmcnt(0)":::"memory");
    #pragma unroll
    for(int i=0;i<4;++i){const int row=i*8+(lane>>3),ch=lane&7; const u32x4 v=*(const u32x4*)(stg+row*64+ch*8); ATTN_STORE16(Ow+(long)row*DM+ch*8,v);} }
  asm volatile("s_waitcnt lgkmcnt(0)\n\ts_barrier":::"memory");
  #undef DMA_K
  #undef DMA_V
  #undef CMASK
  #undef START
  #undef RESC
  #undef ROT
}
constexpr int ATTN_LDS_BYTES=LDS_BYTES;
__device__ __forceinline__ void qkt0(f32x16&p0,f32x16&p1,const char*Kslot,const bf16x8*qr,int r32,int hi){
  const char*kb=Kslot+hi*1024+r32*16; const f32x16 z=f32x16{};
  #pragma unroll
  for(int d0=0;d0<4;++d0){
    const bf16x8 b0=*reinterpret_cast<const bf16x8*>(kb+d0*2048);
    const bf16x8 b1=*reinterpret_cast<const bf16x8*>(kb+d0*2048+512);
    if(d0==0){p0=__builtin_amdgcn_mfma_f32_32x32x16_bf16(b0,qr[0],z,0,0,0);p1=__builtin_amdgcn_mfma_f32_32x32x16_bf16(b1,qr[0],z,0,0,0);}
    else{p0=__builtin_amdgcn_mfma_f32_32x32x16_bf16(b0,qr[d0],p0,0,0,0);p1=__builtin_amdgcn_mfma_f32_32x32x16_bf16(b1,qr[d0],p1,0,0,0);}}
}
__device__ __forceinline__ const char* mk_ws_ptr();
__device__ __forceinline__ const float* mk_in_ptr(int k);
constexpr int U2_VS=4;
constexpr int U2_K=0, U2_VA=NSLOT*SLOTB, U2_VB=U2_VA+U2_VS*SLOTB, U2_WS=U2_VB+U2_VS*SLOTB, U2_OST=U2_WS+NW*64*4, U2_BYTES=U2_OST+NW*4096;
template<int THRL,int MODE> __device__ __forceinline__ void attn_unit2(int b,int qcol,int kcol,int vcol,int ocol,int qb,size_t q_off,size_t k_off,size_t v_off,size_t o_off,size_t o0_off,int subg_idx,char*shm,float lam,
    bf16x8 (&qr)[4],bool pre,bool hasn,int nb,int nqcol,int nkcol,int nvcol,int nqb){
  const bf16*Q,*K,*V; { const char*w_=mk_ws_ptr(); Q=(const bf16*)(w_+q_off); K=(const bf16*)(w_+k_off); V=(const bf16*)(w_+v_off); }
  int tid_=threadIdx.x; asm volatile("":"+v"(tid_));
  const int tid=tid_,lane=tid&63,r32=lane&31,hi=lane>>5; const int wid=__builtin_amdgcn_readfirstlane(tid>>6);
  const long rowbase=(long)b*SEQ; const int q0=qb*QB;
  const bf16*Qw=Q+(rowbase+q0+wid*QBLK)*DM+qcol;
  const bf16*Kh=K+rowbase*DM+kcol,*Vh=V+rowbase*DM+vcol;
  const unsigned lds0=(unsigned)(uintptr_t)shm;
  float*wsf=(float*)(shm+U2_WS)+wid*64;
  const bf16*ksrc=Kh+(long)lane*DM+wid*8;
  const bf16*vsrc=Vh+(long)(16*(wid&3)+(lane>>2))*DM+(wid>>2)*32+(lane&3)*8;
  const unsigned kdst=lds0+U2_K+wid*1024, vdstA=lds0+U2_VA+wid*1024, vdstB=lds0+U2_VB+wid*1024;
  #define RFL(x) ((unsigned)__builtin_amdgcn_readfirstlane(x))
  #define DMAK(n,slot) glds16(ksrc+(long)(n)*KVBLK*DM,RFL(kdst+(slot)))
  #define DMAV(n,slot) do{ glds16(vsrc+(long)(n)*KVBLK*DM,RFL(vdstA+(slot))); glds16(vsrc+(long)(n)*KVBLK*DM+64,RFL(vdstB+(slot))); }while(0)
  const int vbo=((lane>>4)&1)*32+(lane&3)*8+(4*hi+((lane&15)>>2))*64;
  const char*Kbase=shm+U2_K;
  const int NT=(q0+QB)/KVBLK;
  if(!pre){
    #pragma unroll
    for(int d0=0;d0<4;++d0)qr[d0]=*reinterpret_cast<const bf16x8*>(&Qw[(long)r32*DM+d0*16+hi*8]);
    asm volatile("":::"memory");
    DMAK(0,0); DMAV(0,0); DMAK(1,SLOTB); DMAV(1,SLOTB); DMAK(2,2*SLOTB);
  }
  float mhat=0.f,l_reg=0.f; f32x16 o[4]; o[0]=f32x16{};o[1]=f32x16{};o[2]=f32x16{};o[3]=f32x16{};
  const int qrel=wid*QBLK+r32;
  u32x4 pw[4];
  u32x4 g0_[2][4];
  const lds_cptr shm3=(lds_cptr)shm; const lds_cptr vpA0=shm3+U2_VA+vbo, vpB0=shm3+U2_VB+vbo, kp0=shm3+U2_K+hi*1024+r32*16;
  #define PKV(L,H) (bf16x8){L[0],L[1],L[2],L[3],H[0],H[1],H[2],H[3]}
  #define PIN(x) asm volatile("":"+v"(x))
  #define KLD(kp,q) (*(const __attribute__((address_space(3))) bf16x8*)((kp)+((q)>>1)*2048+((q)&1)*512))
  #define STEP2(PC0,PC1,PN0,PN1,t,FIRST,HASPV,HASQK,PREF) do{ \
    if((t)+2<NT){WAIT_BAR(3);}else if((t)+1<NT){WAIT_BAR(2);}else{WAIT_BAR(0);}     \
    if(PREF&&MODE==1){ const bf16*o0w_=(const bf16*)(mk_ws_ptr()+o0_off)+((long)b*SEQ+(long)qb*QB+wid*QBLK)*DM+ocol; \
      _Pragma("unroll") for(int h2=0;h2<2;++h2) _Pragma("unroll") for(int i=0;i<4;++i){const int row=i*8+(lane>>3),ch=lane&7; g0_[h2][i]=*(const u32x4*)(o0w_+(long)row*DM+h2*64+ch*8);} } \
    if(PREF){ if(hasn){ const char*wn_=mk_ws_ptr(); const long nrb_=(long)nb*SEQ; \
        const bf16*nks_=(const bf16*)(wn_+k_off)+nrb_*DM+nkcol+(long)lane*DM+wid*8; \
        const bf16*nvs_=(const bf16*)(wn_+v_off)+nrb_*DM+nvcol+(long)(16*(wid&3)+(lane>>2))*DM+(wid>>2)*32+(lane&3)*8; \
        const bf16*nqw_=(const bf16*)(wn_+q_off)+(nrb_+(long)nqb*QB+wid*QBLK)*DM+nqcol; \
        glds16(nks_,RFL(kdst)); glds16(nvs_,RFL(vdstA)); glds16(nvs_+64,RFL(vdstB)); \
        glds16(nks_+(long)KVBLK*DM,RFL(kdst+SLOTB)); glds16(nvs_+(long)KVBLK*DM,RFL(vdstA+SLOTB)); glds16(nvs_+(long)KVBLK*DM+64,RFL(vdstB+SLOTB)); \
        glds16(nks_+2L*KVBLK*DM,RFL(kdst+2*SLOTB)); \
        _Pragma("unroll") for(int d0=0;d0<4;++d0)qr[d0]=*reinterpret_cast<const bf16x8*>(&nqw_[(long)r32*DM+d0*16+hi*8]); } } \
    const lds_cptr vpA=vpA0+(((t)+3)&3)*SLOTB, vpB=vpB0+(((t)+3)&3)*SLOTB, kp=kp0+(((t)+1)%3)*SLOTB; \
    s16x4 fl[4],fh[4]; bf16x8 kf[2]; float sacc=0.f; \
    SBAR(); \
    if(HASPV){ fl[0]=vtr(vpA); fh[0]=vtr(vpA+512); fl[1]=vtr(vpA+4096); fh[1]=vtr(vpA+4096+512); } \
    if(HASQK){ kf[0]=KLD(kp,0); } \
    SBAR(); \
      \
    if((t)+3<NT)DMAK((t)+3,((t)%3)*SLOTB); \
    if((t)+2<NT)DMAV((t)+2,(((t)+2)&3)*SLOTB); \
      \
    if(HASPV){ _Pragma("unroll") for(int i=0;i<4;++i){ \
        { const int g=i+2, jj=g&3, ks=g>>2; const lds_cptr vp=((jj>>1)?vpB:vpA)+((jj&1)*4096+ks*1024); fl[g&3]=vtr(vp); fh[g&3]=vtr(vp+512); } \
        o[i]=__builtin_amdgcn_mfma_f32_32x32x16_bf16(__builtin_bit_cast(bf16x8,pw[0]),PKV(fl[i],fh[i]),o[i],0,0,0); SBAR(); } } \
    float rm; \
    { float a=__builtin_fmaxf(__builtin_fmaxf(PC0[0],PC0[1]),PC1[0]),bb=__builtin_fmaxf(__builtin_fmaxf(PC0[2],PC0[3]),PC1[1]); a=__builtin_fmaxf(__builtin_fmaxf(a,PC1[2]),PC1[3]); \
      _Pragma("unroll") for(int r=4;r<16;r+=4){a=__builtin_fmaxf(__builtin_fmaxf(a,PC0[r]),PC0[r+1]);bb=__builtin_fmaxf(__builtin_fmaxf(bb,PC0[r+2]),PC0[r+3]);a=__builtin_fmaxf(__builtin_fmaxf(a,PC1[r]),PC1[r+1]);bb=__builtin_fmaxf(__builtin_fmaxf(bb,PC1[r+2]),PC1[r+3]);} \
      rm=__builtin_fmaxf(a,bb); auto rr=__builtin_amdgcn_permlane32_swap(__float_as_uint(rm),__float_as_uint(rm),false,false); rm=__builtin_fmaxf(__uint_as_float(rr[0]),__uint_as_float(rr[1])); } \
    bool resc=false; \
      \
    if(FIRST){ mhat=rm;                                       \
      _Pragma("unroll") for(int r=0;r<16;++r){PC0[r]-=rm;PC1[r]-=rm;} \
      _Pragma("unroll") for(int r=0;r<16;++r)negm[r]=-mhat; asm volatile("":"+v"(negm)); } \
    else if(__any(rm>(float)THRL)){ const float dl=__builtin_fmaxf(rm,0.f); mhat+=dl;     \
      _Pragma("unroll") for(int r=0;r<16;++r){PC0[r]-=dl;PC1[r]-=dl;} \
      _Pragma("unroll") for(int r=0;r<16;++r)negm[r]=-mhat; asm volatile("":"+v"(negm)); \
      const float f=__builtin_amdgcn_exp2f(-dl); l_reg*=f; if(hi==0)wsf[r32]=f; resc=true; } \
    SBAR(); \
      \
    _Pragma("unroll") for(int i=4;i<16;++i){ \
      if(HASPV&&i+2<16){ const int g=i+2, jj=g&3, ks=g>>2; const lds_cptr vp=((jj>>1)?vpB:vpA)+((jj&1)*4096+ks*1024); fl[g&3]=vtr(vp); fh[g&3]=vtr(vp+512); } \
      if(HASQK){ const int q=(i<8)?(i-4):(((i&1)==0)?(4+((i-8)>>1)):-1); \
        if(q>=0){ if(q+1<8) kf[(q+1)&1]=KLD(kp,q+1); const int d0=q>>1; \
          if((q&1)==0) PN0=__builtin_amdgcn_mfma_f32_32x32x16_bf16(kf[q&1],qr[d0],(q<2)?negm:PN0,0,0,0); else PN1=__builtin_amdgcn_mfma_f32_32x32x16_bf16(kf[q&1],qr[d0],(q<2)?negm:PN1,0,0,0); } } \
      if(HASPV){ const int jj=i&3, ks=i>>2; o[jj]=__builtin_amdgcn_mfma_f32_32x32x16_bf16(__builtin_bit_cast(bf16x8,pw[ks]),PKV(fl[i&3],fh[i&3]),o[jj],0,0,0); } \
      if(i<8){ const int b0_=4*(i-4); float e0=__builtin_amdgcn_exp2f(PC0[b0_]),e1=__builtin_amdgcn_exp2f(PC0[b0_+1]),e2=__builtin_amdgcn_exp2f(PC0[b0_+2]),e3=__builtin_amdgcn_exp2f(PC0[b0_+3]); \
        PC0[b0_]=e0;PC0[b0_+1]=e1;PC0[b0_+2]=e2;PC0[b0_+3]=e3; sacc+=e0; sacc+=e1; sacc+=e2; sacc+=e3; PIN(sacc); } \
      else { const int b1_=2*i-16; float e0=__builtin_amdgcn_exp2f(PC1[b1_]),e1=__builtin_amdgcn_exp2f(PC1[b1_+1]); PC1[b1_]=e0;PC1[b1_+1]=e1; sacc+=e0; sacc+=e1; PIN(sacc); } \
      if(i==6||i==7){ const int w=2*(i-6); pw[0][w]=cvtpk_s(PC0[2*w],PC0[2*w+1]); pw[0][w+1]=cvtpk_s(PC0[2*w+2],PC0[2*w+3]); PIN(pw[0]); } \
      if(i==8||i==9){ const int w=2*(i-8); pw[1][w]=cvtpk_s(PC0[8+2*w],PC0[8+2*w+1]); pw[1][w+1]=cvtpk_s(PC0[8+2*w+2],PC0[8+2*w+3]); PIN(pw[1]); } \
      if(i==12||i==13){ const int w=2*(i-12); pw[2][w]=cvtpk_s(PC1[2*w],PC1[2*w+1]); pw[2][w+1]=cvtpk_s(PC1[2*w+2],PC1[2*w+3]); PIN(pw[2]); } \
      SBAR(); \
    } \
    _Pragma("unroll") for(int w=0;w<4;++w)pw[3][w]=cvtpk_s(PC1[8+2*w],PC1[8+2*w+1]); \
    l_reg+=sacc; \
    if(resc){ asm volatile("s_waitcnt lgkmcnt(0)":::"memory"); \
      _Pragma("unroll") for(int r=0;r<16;++r){ const float fr_=wsf[crow(r,hi)]; \
        _Pragma("unroll") for(int d_=0;d_<4;++d_)o[d_][r]*=fr_; } \
      asm volatile("s_waitcnt lgkmcnt(0)":::"memory"); } \
    if(HASQK){ const int jb=(t)+1-(NT-4); if(jb>=0)cmask(PN0,PN1,jb,qrel,hi); } \
  }while(0)
  f32x16 negm=f32x16{}; asm volatile("":"+v"(negm));
  if(wid>=4)__builtin_amdgcn_s_setprio(1);
  f32x16 pA0,pA1,pB0,pB1;
  if(pre){WAIT_BAR(0);}else{WAIT_BAR(6);}
  qkt0(pA0,pA1,Kbase,qr,r32,hi);
  { const int jb=0-(NT-4); if(jb>=0)cmask(pA0,pA1,jb,qrel,hi); }
  STEP2(pA0,pA1,pB0,pB1,0,true,false,true,0);
  int t=1;
  for(;t+1<NT;t+=2){
    STEP2(pB0,pB1,pA0,pA1,t,false,true,true,0);
    STEP2(pA0,pA1,pB0,pB1,t+1,false,true,true,0);
  }
  STEP2(pB0,pB1,pA0,pA1,t,false,true,false,1);
  { const int vs_=((NT-1)&3)*SLOTB; const lds_cptr vpA=vpA0+vs_, vpB=vpB0+vs_;
    #pragma unroll
    for(int jj=0;jj<4;++jj){ const lds_cptr vb_=((jj>>1)?vpB:vpA)+(jj&1)*4096; s16x4 l_[4],h_[4];
      #pragma unroll
      for(int ks=0;ks<4;++ks){ l_[ks]=vtr(vb_+ks*1024); h_[ks]=vtr(vb_+ks*1024+512); }
      #pragma unroll
      for(int ks=0;ks<4;++ks)o[jj]=__builtin_amdgcn_mfma_f32_32x32x16_bf16(__builtin_bit_cast(bf16x8,pw[ks]),PKV(l_[ks],h_[ks]),o[jj],0,0,0); } }
  #undef STEP2
  #undef KLD
  #undef PIN
  #undef PKV
  #undef DMAV
  #undef DMAK
  #undef RFL
  __builtin_amdgcn_s_setprio(0);
  {auto rr=__builtin_amdgcn_permlane32_swap(__float_as_uint(l_reg),__float_as_uint(l_reg),false,false);l_reg=__uint_as_float(rr[0])+__uint_as_float(rr[1]);}
  if(hi==0)wsf[32+r32]=l_reg;asm volatile("s_waitcnt lgkmcnt(0)":::"memory");
  float rli[16];
  #pragma unroll
  for(int r=0;r<16;++r)rli[r]=__builtin_amdgcn_rcpf(wsf[32+crow(r,hi)]);
  const char*we_=mk_ws_ptr();
  bf16*Ow=(bf16*)(we_+o_off)+(rowbase+q0+wid*QBLK)*DM+ocol;
  bf16*stg=(bf16*)(shm+U2_OST)+wid*2048;
  #pragma unroll
  for(int r=0;r<16;++r){
    #pragma unroll
    for(int jj=0;jj<4;++jj)o[jj][r]*=rli[r];}
  if(MODE==1){
    const float*sub_g=mk_in_ptr(subg_idx);
    #pragma unroll
    for(int h2=0;h2<2;++h2){
      #pragma unroll
      for(int i=0;i<4;++i){const int row=i*8+(lane>>3),ch=lane&7; *(u32x4*)(stg+row*64+ch*8)=g0_[h2][i];}
      asm volatile("s_waitcnt lgkmcnt(0)":::"memory");
      #pragma unroll
      for(int r=0;r<16;++r){const int orow=crow(r,hi);
        #pragma unroll
        for(int d0=0;d0<2;++d0){ const float o0=__bfloat162float(stg[orow*64+d0*32+r32]); o[2*h2+d0][r]=o0-lam*o[2*h2+d0][r]; } }
      asm volatile("s_waitcnt lgkmcnt(0)":::"memory");
    }
    float sgv[4];
    #pragma unroll
    for(int jj=0;jj<4;++jj)sgv[jj]=sub_g[jj*32+r32]*(1.0f-0.35550906759096934f);
    #pragma unroll
    for(int r=0;r<16;++r){ float ss=(o[0][r]*o[0][r]+o[1][r]*o[1][r])+(o[2][r]*o[2][r]+o[3][r]*o[3][r]);
      ss+=__shfl_xor(ss,1); ss+=__shfl_xor(ss,2); ss+=__shfl_xor(ss,4); ss+=__shfl_xor(ss,8); ss+=__shfl_xor(ss,16);
      const float sc_=1.0f/sqrtf(ss*(1.0f/128.0f)+1e-5f);
      #pragma unroll
      for(int jj=0;jj<4;++jj)o[jj][r]*=sc_*sgv[jj]; }
  }
  #pragma unroll
  for(int h2=0;h2<2;++h2){
    #pragma unroll
    for(int r=0;r<16;++r){const int orow=crow(r,hi);
      #pragma unroll
      for(int d0=0;d0<2;++d0)stg[orow*64+d0*32+r32]=__float2bfloat16(o[2*h2+d0][r]);}
    asm volatile("s_waitcnt lgkmcnt(0)":::"memory");
    #pragma unroll
    for(int i=0;i<4;++i){const int row=i*8+(lane>>3),ch=lane&7; const u32x4 v=*(const u32x4*)(stg+row*64+ch*8); ATTN_STORE16(Ow+(long)row*DM+h2*64+ch*8,v);}
    asm volatile("s_waitcnt lgkmcnt(0)":::"memory");
  }
  if(MODE==0)asm volatile("s_waitcnt vmcnt(0)":::"memory");
  asm volatile("s_waitcnt lgkmcnt(0)\n\ts_barrier":::"memory");
}
struct AttnUnit { int b, hc, vh, qb; };
__device__ __forceinline__ bool attn_next(int i,int G,int vcu,AttnUnit&u){
  const int L=i*G+vcu; if(L>=4096)return false;
  int combo,qb;
  if(G==256){ const int x=vcu>>5, c=vcu&31; combo=16*x+i; qb=(i&1)?31-c:c; }
  else { const int v=L&255, ii=L>>8, s=v&1, x=2*(ii>>1)+s; combo=v>>1; qb=(ii&1)?31-x:x; }
  u.qb=qb; u.vh=combo&1; u.hc=(combo>>1)&15; u.b=combo>>5; return true;
}
template<int THRL=8> __device__ __forceinline__ void attn_phase(char*lds,const bf16*Q,const bf16*K,const bf16*V,bf16*O0,bf16*O1,int G,int vcu){
  AttnUnit u;
  for(int i=0;attn_next(i,G,vcu,u);++i){
    const int vcol=(u.hc>>1)*128+u.vh*64;
    attn_unit<THRL>(u.b,u.hc*64,u.hc*64,vcol,vcol,u.qb,Q,K,V,(u.hc&1)?O1:O0,lds);
  }
}
__device__ __forceinline__ bool attn_next2(int i,int G,int vcu,int&bb,int&h,int&qb){
  const int L=i*G+vcu; if(L>=1024)return false;
  int hg;
  if(G==256){ const int x=vcu>>5, c=vcu&31; hg=4*x+i; qb=(i&1)?31-c:c; }
  else { hg=L>>5; qb=L&31; }
  h=hg&7; bb=hg>>3; return true;
}
template<int THRL=8> __device__ __forceinline__ void attn_phase2(char*lds,size_t q_off,size_t k_off,size_t v_off,size_t o0_off,size_t at_off,int lamq_idx,int lamk_idx,int subg_idx,int G,int vcu){
  const int lane=threadIdx.x&63;
  float lam;
  { const float*lam_q=mk_in_ptr(lamq_idx); const float*lam_k=mk_in_ptr(lamk_idx);
    float d0=lam_q[lane]*lam_k[lane], d1=lam_q[64+lane]*lam_k[64+lane];
    #pragma unroll
    for(int o_=1;o_<64;o_<<=1){ d0+=__shfl_xor(d0,o_); d1+=__shfl_xor(d1,o_); }
    lam=expf(d0)-expf(d1)+0.35550906759096934f; }
  int bb,h,qb; bf16x8 qr[4]; bool pre=false;
  #pragma unroll
  for(int d0=0;d0<4;++d0)qr[d0]=bf16x8{};
  for(int i=0;attn_next2(i,G,vcu,bb,h,qb);++i){
    const int vcol=h*128; int nb_=0,nh_=0,nq_=0; const bool hn=attn_next2(i+1,G,vcu,nb_,nh_,nq_);
    attn_unit2<THRL,0>(bb,(2*h)*64,(2*h)*64,vcol,vcol,qb,q_off,k_off,v_off,o0_off,0,subg_idx,lds,0.f, qr,pre,true,bb,(2*h+1)*64,(2*h+1)*64,vcol,qb);
    attn_unit2<THRL,1>(bb,(2*h+1)*64,(2*h+1)*64,vcol,vcol,qb,q_off,k_off,v_off,at_off,o0_off,subg_idx,lds,lam, qr,true,hn,nb_,(2*nh_)*64,(2*nh_)*64,nh_*128,nq_);
    pre=true;
  }
}
#undef SBAR
#undef WAIT_BAR
}

constexpr int NWAVES = 8;
#ifndef REP_DEFAULTS
constexpr int REP_P0 = 1, REP_P1 = 1, REP_P2 = 1, REP_P3 = 1, REP_P4 = 1, REP_P5 = 1, REP_P6 = 1, REP_P7 = 1, REP_P7b = 1, REP_P8 = 1, REP_P9 = 1, REP_P10 = 1, REP_P11 = 1, REP_SYNC = 1;
#endif
constexpr size_t MiB = 1u << 20;
constexpr size_t WS_CTL = 0;
constexpr size_t WS_ROPE = 1 * MiB;
constexpr size_t WS_WSB = 1 * MiB + 512 * 1024;
constexpr size_t WS_RMS = 2 * MiB;
constexpr size_t WS_LNS = 4 * MiB;
constexpr size_t WS_W = 12 * MiB;
constexpr size_t WO_IN = 0, WO_OUT = 8 * MiB, WO_GU0 = 12 * MiB, WO_DN0 = 23 * MiB, WO_KVQ = 28 * MiB + 512 * 1024, WO_O = 34 * MiB + 512 * 1024, WO_GU1 = 36 * MiB + 512 * 1024, WO_DN1 = 47 * MiB + 512 * 1024;
constexpr size_t WS_HB = 72 * MiB;
constexpr size_t WS_A = 136 * MiB;
constexpr size_t A_U = 0, A_V = 128 * MiB;
constexpr size_t A_ACT = 0;
constexpr size_t A_K = 0, A_VV = 64 * MiB, A_Q = 128 * MiB, A_O0 = 192 * MiB, A_O1 = 256 * MiB, A_AT = 256 * MiB;
constexpr size_t WS_END = WS_A + 320 * MiB;
constexpr int RING_OFF = 0, RING_BYTES = 131072;
constexpr int LDS_BYTES = 147456;
constexpr int MISC_OFF = RING_BYTES + 320;

#define GAS __attribute__((address_space(1)))
#define LAS __attribute__((address_space(3)))
typedef unsigned short bf16;
typedef unsigned v4u __attribute__((ext_vector_type(4)));
typedef float f32x4 __attribute__((ext_vector_type(4)));
typedef float f32x16 __attribute__((ext_vector_type(16)));
typedef short bf16x8 __attribute__((ext_vector_type(8)));
#define LDS_WAIT() asm volatile("s_waitcnt lgkmcnt(0)" ::: "memory")
__device__ __forceinline__ unsigned f2bf(float f) { unsigned u = __builtin_bit_cast(unsigned, f); return (u + 0x7fffu + ((u >> 16) & 1u)) >> 16; }
__device__ __forceinline__ unsigned pk2(float lo, float hi) { return f2bf(lo) | (f2bf(hi) << 16); }
__device__ __forceinline__ float bflo(unsigned w) { return __uint_as_float(w << 16); }
__device__ __forceinline__ float bfhi(unsigned w) { return __uint_as_float(w & 0xffff0000u); }
__device__ __forceinline__ float wave_sum(float v) {
#pragma unroll
    for (int o = 1; o < 64; o <<= 1) v += __shfl_xor(v, o);
    return v;
}
struct P0Item { const float* W; bf16* WT; const float* kscale; int K, N, row_off, mode, item; };
__device__ __forceinline__ void p0_item_load(const P0Item& d, float (&wv)[32], int lane) {
    const int nblk = d.N / 32, kb = d.item / nblk, nb = d.item % nblk, k0 = 64 * kb, n0 = 32 * nb;
#pragma unroll
    for (int i = 0; i < 32; ++i) wv[i] = d.W[(size_t)(k0 + 2 * i + (lane >> 5)) * d.N + n0 + (lane & 31)];
}
__device__ __forceinline__ void p0_item_store(const P0Item& d, float (&wv)[32], LAS float* scr, int lane) {
    const int K = d.K, nblk = d.N / 32, kb = d.item / nblk, nb = d.item % nblk, k0 = 64 * kb, n0 = 32 * nb;
    if (d.kscale) {
#pragma unroll
        for (int i = 0; i < 32; ++i) wv[i] *= d.kscale[k0 + 2 * i + (lane >> 5)]; }
#pragma unroll
    for (int i = 0; i < 32; ++i) scr[(2 * i + (lane >> 5)) * 33 + (lane & 31)] = wv[i];
    LDS_WAIT(); asm volatile("" ::: "memory");
    int d0 = d.row_off + n0;
    if (d.mode == 1) { const int half = n0 / DFF, r = n0 % DFF; d0 = 256 * (r / 128) + 128 * half + (r % 128); }
    const int c = lane & 7;
#pragma unroll
    for (int j = 0; j < 4; ++j) { const int n = (lane >> 3) + 8 * j; const LAS float* s = scr + (8 * c) * 33 + n;
        v4u o; o.x = pg8::cvt_pk_bf16(s[0 * 33], s[1 * 33]); o.y = pg8::cvt_pk_bf16(s[2 * 33], s[3 * 33]); o.z = pg8::cvt_pk_bf16(s[4 * 33], s[5 * 33]); o.w = pg8::cvt_pk_bf16(s[6 * 33], s[7 * 33]);
        *(GAS v4u*)(d.WT + (size_t)(d0 + n) * K + k0 + 8 * c) = o; }
    LDS_WAIT(); asm volatile("" ::: "memory");
}
#define RLX_AGENT __ATOMIC_RELAXED, __HIP_MEMORY_SCOPE_AGENT
#define XB_TMO      128
#define XB_XCNT(j)  (256  + 64 * (j))
#define XB_XSUB(j)  (1280 + 64 * (j))
#define XB_XGEN(j)  (2304 + 64 * (j))
#define XB_TOP      3328
#define XB_TOPGEN   3392
#define XCD_BAR_WORDS 3456
#define XB_SPIN_CAP (1u << 18)

__device__ __forceinline__ unsigned xb_ld(unsigned* p)              { return __hip_atomic_load(p, __ATOMIC_RELAXED, __HIP_MEMORY_SCOPE_AGENT); }
__device__ __forceinline__ unsigned xb_add(unsigned* p, unsigned v) { return __hip_atomic_fetch_add(p, v, __ATOMIC_RELAXED, __HIP_MEMORY_SCOPE_AGENT); }
__device__ __forceinline__ unsigned xb_xcc_id() { return (unsigned)__builtin_amdgcn_s_getreg((3 << 11) | 20) & 0xFu; }
#define XB_SPIN(cond, bar) do { unsigned _sp = 0; while (cond) { __builtin_amdgcn_s_sleep(1); \
    if ((++_sp & 255u) == 0u) { if (xb_ld(&(bar)[XB_TMO])) break; if (_sp > XB_SPIN_CAP) { atomicAdd(&(bar)[XB_TMO], 1u); break; } } } } while (0)

struct XcdBarrier {
    unsigned* bar; unsigned x;
    volatile LAS unsigned* st;
};

__device__ __forceinline__ XcdBarrier xcd_barrier_post(unsigned* bar, volatile LAS unsigned* st) {
    XcdBarrier b; b.bar = bar; b.x = xb_xcc_id(); b.st = st;
    if (threadIdx.x == 0) (void)xb_add(&bar[XB_XCNT(b.x)], 1u);
    return b;
}
__device__ __forceinline__ void xcd_barrier_complete(unsigned* bar, unsigned x, unsigned& nloc, unsigned& nx) {
    const unsigned G = gridDim.x * gridDim.y * gridDim.z;
    unsigned sum, cnt, mine, sp = 0u;
    for (;;) {
        sum = 0u; cnt = 0u; mine = 0u;
#pragma unroll
        for (unsigned j = 0; j < 16; ++j) { const unsigned c = xb_ld(&bar[XB_XCNT(j)]); sum += c; cnt += (c > 0u) ? 1u : 0u; mine = (j == x) ? c : mine; }
        if (sum == G) break;
        __builtin_amdgcn_s_sleep(1);
        if ((++sp & 255u) == 0u) { if (xb_ld(&bar[XB_TMO])) break; if (sp > XB_SPIN_CAP) { atomicAdd(&bar[XB_TMO], 1u); break; } }
    }
    nloc = mine > 0u ? mine : 1u; nx = cnt > 0u ? cnt : 1u;
}

__device__ __forceinline__ void xcd_barrier(const XcdBarrier& b) {
    asm volatile("s_waitcnt vmcnt(0)" ::: "memory");
    __syncthreads();
    if (threadIdx.x == 0) {
        unsigned* bar = b.bar;
        __builtin_amdgcn_s_waitcnt(0);
        unsigned nloc = b.st[0], nx = b.st[1];
        if (nloc == 0u) { xcd_barrier_complete(bar, b.x, nloc, nx); b.st[0] = nloc; b.st[1] = nx; }
        const unsigned old = xb_add(&bar[XB_XSUB(b.x)], 1u);
        const unsigned gen = old / nloc;
        if (old + 1u == (gen + 1u) * nloc) {
            __builtin_amdgcn_fence(__ATOMIC_RELEASE, "agent");
            asm volatile("s_waitcnt vmcnt(0)" ::: "memory");
            const unsigned og = xb_add(&bar[XB_TOP], 1u);
            const unsigned tg = og / nx;
            if (og + 1u == (tg + 1u) * nx) xb_add(&bar[XB_TOPGEN], 1u);
            else XB_SPIN(xb_ld(&bar[XB_TOPGEN]) == tg, bar);
            __builtin_amdgcn_fence(__ATOMIC_ACQUIRE, "agent");
            asm volatile("s_waitcnt vmcnt(0)" ::: "memory");
        } else {
            XB_SPIN(xb_ld(&bar[XB_TOPGEN]) == gen, bar);
            __builtin_amdgcn_fence(__ATOMIC_ACQUIRE, "agent");
            asm volatile("s_waitcnt vmcnt(0)" ::: "memory");
        }
    }
    __syncthreads();
}
struct Args { const float* in[19]; float* out; unsigned char* ws; };
enum { I_X = 0, I_ATTN_G, I_FFN_G, I_W_IN, I_LN_G, I_LN_B, I_W_S, I_B_S, I_W_OUT, I_KV_G, I_W_KV, I_W_Q, I_LAM_Q, I_LAM_K, I_SUB_G, I_W_O, I_W_GU, I_W_DOWN, I_FINAL_G };

typedef const Args __attribute__((address_space(4)))* KArgs;
namespace attn_body {
__device__ __forceinline__ const char* mk_ws_ptr() { KArgs p_ = (KArgs)__builtin_amdgcn_kernarg_segment_ptr(); asm volatile("" : "+s"(p_)); return (const char*)p_->ws; }
__device__ __forceinline__ const float* mk_in_ptr(int k) { KArgs p_ = (KArgs)__builtin_amdgcn_kernarg_segment_ptr(); asm volatile("" : "+s"(p_)); return p_->in[k]; }
}
#define PHASE_BEGIN() KArgs A_; { KArgs p_ = (KArgs)__builtin_amdgcn_kernarg_segment_ptr(); asm volatile("" : "+s"(p_)); A_ = p_; } \
    unsigned char* ws = A_->ws; int tid = threadIdx.x; asm volatile("" : "+v"(tid)); const int lane = tid & 63, wave = __builtin_amdgcn_readfirstlane(tid >> 6); (void)lane; (void)wave; (void)ws
#define IN_(k) (A_->in[k])
#define WSB_(off) ((bf16*)(ws + (off)))
#define WSF_(off) ((float*)(ws + (off)))
__global__ void __launch_bounds__(NWAVES * 64, 2) mk_fwd(Args args) {
    extern __shared__ __attribute__((aligned(16))) unsigned char lds_raw[];
    cg::grid_group grid = cg::this_grid();
    LAS unsigned char* lds = (LAS unsigned char*)lds_raw;
    const int G = gridDim.x; const int bx = blockIdx.x; const int vcu = (G % 8 == 0) ? (bx % 8) * (G / 8) + bx / 8 : bx;
    const int NGW = G * NWAVES;
    for (int u = threadIdx.x; u < 32; u += NWAVES * 64) ((LAS unsigned*)(lds + MISC_OFF))[u] = 0u;
    __syncthreads();
#define GRID_BAR() do { KArgs p_ = (KArgs)__builtin_amdgcn_kernarg_segment_ptr(); asm volatile("" : "+s"(p_)); XcdBarrier b_; b_.bar = (unsigned*)(p_->ws + WS_CTL); b_.x = xb_xcc_id(); b_.st = (volatile LAS unsigned*)(lds + MISC_OFF) + 8; xcd_barrier(b_); } while (0)

    for (int rep_ = 0; rep_ < REP_P0; ++rep_)
    {
        PHASE_BEGIN(); const int gw = vcu * NWAVES + wave;
        LAS float* scr = (LAS float*)(lds + RING_OFF + wave * 16384);
        float* rope = WSF_(WS_ROPE); bf16* Wsb = WSB_(WS_WSB); bf16* HB = WSB_(WS_HB);
        bf16 *W_in_t = WSB_(WS_W + WO_IN), *W_out_t = WSB_(WS_W + WO_OUT), *W_gu0_t = WSB_(WS_W + WO_GU0), *W_dn0_t = WSB_(WS_W + WO_DN0), *W_kvq_t = WSB_(WS_W + WO_KVQ), *W_o_t = WSB_(WS_W + WO_O), *W_gu1_t = WSB_(WS_W + WO_GU1), *W_dn1_t = WSB_(WS_W + WO_DN1);
        constexpr int IT_IN = (DMODEL / 64) * (4096 / 32), IT_OUT = (GWIDTH / 64) * (DMODEL / 32), IT_GU = (DMODEL / 64) * (2 * DFF / 32), IT_DN = (DFF / 64) * (DMODEL / 32),
                      IT_KV = (DMODEL / 64) * (2048 / 32), IT_Q = (DMODEL / 64) * (DMODEL / 32), IT_O = IT_Q;
        constexpr int NITEMS = IT_IN + IT_OUT + 2 * IT_GU + 2 * IT_DN + IT_KV + IT_Q + IT_O;
        const float* ffn_g = IN_(I_FFN_G);
#define P0_DESC(D, IT) do { int r = (IT); \
            if (r < IT_IN) { D = P0Item{IN_(I_W_IN), W_in_t, nullptr, DMODEL, 4096, 0, 0, r}; break; } r -= IT_IN; \
            if (r < IT_OUT) { D = P0Item{IN_(I_W_OUT), W_out_t, nullptr, GWIDTH, DMODEL, 0, 0, r}; break; } r -= IT_OUT; \
            if (r < IT_GU) { D = P0Item{IN_(I_W_GU), W_gu0_t, ffn_g, DMODEL, 2 * DFF, 0, 1, r}; break; } r -= IT_GU; \
            if (r < IT_GU) { D = P0Item{IN_(I_W_GU) + (size_t)DMODEL * 2 * DFF, W_gu1_t, ffn_g + DMODEL, DMODEL, 2 * DFF, 0, 1, r}; break; } r -= IT_GU; \
            if (r < IT_DN) { D = P0Item{IN_(I_W_DOWN), W_dn0_t, nullptr, DFF, DMODEL, 0, 0, r}; break; } r -= IT_DN; \
            if (r < IT_DN) { D = P0Item{IN_(I_W_DOWN) + (size_t)DFF * DMODEL, W_dn1_t, nullptr, DFF, DMODEL, 0, 0, r}; break; } r -= IT_DN; \
            if (r < IT_KV) { D = P0Item{IN_(I_W_KV), W_kvq_t, IN_(I_KV_G), DMODEL, 2048, 0, 0, r}; break; } r -= IT_KV; \
            if (r < IT_Q) { D = P0Item{IN_(I_W_Q), W_kvq_t, IN_(I_ATTN_G) + DMODEL, DMODEL, DMODEL, 2048, 0, r}; break; } r -= IT_Q; \
            D = P0Item{IN_(I_W_O), W_o_t, nullptr, DMODEL, DMODEL, 0, 0, r}; } while (0)
        { float wa[32], wb[32]; P0Item da, db; int it = gw;
          if (it < NITEMS) { P0_DESC(da, it); p0_item_load(da, wa, lane); }
          while (it < NITEMS) {
              const int i1 = it + NGW, i2 = it + 2 * NGW;
              if (i1 < NITEMS) { P0_DESC(db, i1); p0_item_load(db, wb, lane); }
              p0_item_store(da, wa, scr, lane);
              if (i1 >= NITEMS) break;
              if (i2 < NITEMS) { P0_DESC(da, i2); p0_item_load(da, wa, lane); }
              p0_item_store(db, wb, scr, lane);
              it = i2; } }
#undef P0_DESC
        { const float* x = IN_(I_X); const GAS f32x4* gp = (const GAS f32x4*)IN_(I_ATTN_G) + lane;
          f32x4 gv[4];
#pragma unroll
          for (int j = 0; j < 4; ++j) gv[j] = gp[64 * j];
          for (int m0 = gw; m0 < MROWS; m0 += 8 * NGW) {
              f32x4 v[8][4]; float s2[8];
#pragma unroll
              for (int k = 0; k < 8; ++k) { const int m = (m0 + k * NGW < MROWS) ? m0 + k * NGW : m0; const GAS f32x4* xr = (const GAS f32x4*)(x + (size_t)m * DMODEL) + lane;
#pragma unroll
                  for (int j = 0; j < 4; ++j) v[k][j] = xr[64 * j]; }
#pragma unroll
              for (int k = 0; k < 8; ++k) { float s = 0.f;
#pragma unroll
                  for (int j = 0; j < 4; ++j) s += (v[k][j].x * v[k][j].x + v[k][j].y * v[k][j].y) + (v[k][j].z * v[k][j].z + v[k][j].w * v[k][j].w);
                  s2[k] = 1.f / sqrtf(wave_sum(s) * (1.f / DMODEL) + NORM_EPS); }
#pragma unroll
              for (int k = 0; k < 8; ++k) { const int m = m0 + k * NGW; if (m < MROWS) { GAS unsigned long long* o8 = (GAS unsigned long long*)(HB + (size_t)m * DMODEL) + lane;
#pragma unroll
                  for (int j = 0; j < 4; ++j) { const f32x4 y = v[k][j] * s2[k] * gv[j]; o8[64 * j] = (unsigned long long)pg8::cvt_pk_bf16(y.x, y.y) | ((unsigned long long)pg8::cvt_pk_bf16(y.z, y.w) << 32); } } }
          } }
        { const int idx = bx * (NWAVES * 64) + tid;
          if (idx < SEQLEN * 8) { const int pos = idx >> 3, i = idx & 7;
              const float invf = (i == 0) ? 1.0f : (i == 1) ? 0.1939227432012558f : (i == 2) ? 0.03760603070259094f : (i == 3) ? 0.007292664609849453f : (i == 4) ? 0.0014142135623842478f
                               : (i == 5) ? 0.00027424818836152554f : (i == 6) ? 5.318296098266728e-05f : 1.0313386155758053e-05f;
              const float angf = (float)pos * invf; const double a = (double)angf;
              const double n = __builtin_rint(a * 0.15915494309189535); const double r = __builtin_fma(-n, 6.283185307179586, a) - n * 2.4492935982947064e-16;
              const double r2 = r * r; double sn = 1.0, cs = 1.0;
#pragma unroll
              for (int k = 14; k >= 1; --k) { sn = 1.0 - sn * r2 / (double)((2 * k) * (2 * k + 1)); cs = 1.0 - cs * r2 / (double)((2 * k - 1) * (2 * k)); }
              sn *= r;
              rope[pos * 16 + i] = (float)cs; rope[pos * 16 + 8 + i] = (float)sn; } }
        { const float* w_s = IN_(I_W_S);
          for (int idx = bx * (NWAVES * 64) + tid; idx < 8 * 128 * 128; idx += G * NWAVES * 64) { const int t = (idx >> 7) & 127, s = idx & 127; Wsb[idx] = (bf16)f2bf(s <= t ? w_s[idx] : 0.f); } }
    }
    { KArgs p_ = (KArgs)__builtin_amdgcn_kernarg_segment_ptr(); asm volatile("" : "+s"(p_)); unsigned* bw_ = (unsigned*)(p_->ws + WS_CTL);
      if (bx == 0) for (int u = threadIdx.x; u < XCD_BAR_WORDS; u += NWAVES * 64) __hip_atomic_store(bw_ + u, 0u, __ATOMIC_RELAXED, __HIP_MEMORY_SCOPE_AGENT); }
    for (int rs_ = 0; rs_ < REP_SYNC; ++rs_) grid.sync();
    { KArgs p_ = (KArgs)__builtin_amdgcn_kernarg_segment_ptr(); asm volatile("" : "+s"(p_)); (void)xcd_barrier_post((unsigned*)(p_->ws + WS_CTL), (volatile LAS unsigned*)(lds + MISC_OFF) + 8); }


#ifndef SKIP_P1
    for (int rep_ = 0; rep_ < REP_P1; ++rep_)
    { PHASE_BEGIN(); pg8::Gemm g{WSB_(WS_HB), WSB_(WS_W + WO_IN), MROWS, 4096, DMODEL}; pg8::StaticOrder S; S.init(MROWS, 4096, G, bx);
      pg8::EpiGeluUV E{WSB_(WS_A + A_U), WSF_(WS_LNS)};
      pg8::gemm_phase<pg8::EpiGeluUV, pg8::StaticOrder, true, true>(lds + RING_OFF, g, S, E); }
#endif
    for (int rs_ = 0; rs_ < REP_SYNC; ++rs_) GRID_BAR();
#ifndef SKIP_P2
    for (int rep_ = 0; rep_ < REP_P2; ++rep_)
    {
        PHASE_BEGIN(); bf16* Ub = WSB_(WS_A + A_U); const bf16* Vb = WSB_(WS_A + A_V); const float* lns = WSF_(WS_LNS); const bf16* Wsb = WSB_(WS_WSB);
#define P2_BAR() asm volatile("s_waitcnt lgkmcnt(0)\n\ts_barrier" ::: "memory")
        constexpr int RS = 528;
        LAS unsigned char* Tl = lds + RING_OFF; LAS float* MS = (LAS float*)(lds + RING_OFF + 128 * RS);
        const float* ln_g = IN_(I_LN_G); const float* ln_b = IN_(I_LN_B); const float* b_s = IN_(I_B_S);
        const int cc = tid & 31, rr = tid >> 5, j = lane & 31, kg = lane >> 5;
        constexpr int WRS = 272;
        LAS unsigned char* WsL = lds + RING_OFF + 69632; LAS float* bsL = (LAS float*)(lds + RING_OFF + 69632 + 128 * WRS);
        int g_loaded = -1; f32x4 g0 = {0.f, 0.f, 0.f, 0.f}, g1 = g0, b0 = g0, b1 = g0;
        f32x4 sa = {0.f, 0.f, 0.f, 0.f}, sb = sa, sc = sa, sd = sa; v4u vraw[8];
#pragma unroll
        for (int p = 0; p < 8; ++p) vraw[p] = (v4u){0u, 0u, 0u, 0u};
#define P2_PREFETCH(UI) do { const int cb_ = (UI) >> 3, g_ = (UI) & 7; const size_t r0_ = (size_t)cb_ * 128; \
            const f32x4* sp_ = (const f32x4*)(lns + (r0_ + (tid >> 2)) * 64 + (tid & 3) * 16); sa = sp_[0]; sb = sp_[1]; sc = sp_[2]; sd = sp_[3]; \
            _Pragma("unroll") for (int p = 0; p < 8; ++p) vraw[p] = *(const v4u*)(Vb + (r0_ + p * 16 + rr) * GWIDTH + g_ * 256 + cc * 8); } while (0)
        if (vcu < 2048) P2_PREFETCH(vcu);
        for (int uidx = vcu; uidx < 2048; uidx += G) {
            const int cb = uidx >> 3, g = uidx & 7; const size_t row0 = (size_t)cb * 128;
            if (g != g_loaded) {
#pragma unroll
                for (int i = 0; i < 4; ++i) { const int idx = tid + 512 * i, row = idx >> 4, ch = idx & 15;
                    *(LAS v4u*)(WsL + row * WRS + ch * 16) = *(const v4u*)(Wsb + (size_t)g * 128 * 128 + row * 128 + ch * 8); }
                if (tid < 128) bsL[tid] = b_s[g * 128 + tid];
                const float* gp = ln_g + g * 256 + cc * 8; const float* bp = ln_b + g * 256 + cc * 8;
                g0 = *(const f32x4*)gp; g1 = *(const f32x4*)(gp + 4); b0 = *(const f32x4*)bp; b1 = *(const f32x4*)(bp + 4);
                g_loaded = g; }
            { const int r = tid >> 2, part = tid & 3;
              float s = ((sa[0] + sa[2]) + (sb[0] + sb[2])) + ((sc[0] + sc[2]) + (sd[0] + sd[2])), q = ((sa[1] + sa[3]) + (sb[1] + sb[3])) + ((sc[1] + sc[3]) + (sd[1] + sd[3]));
              s += __shfl_xor(s, 1); s += __shfl_xor(s, 2); q += __shfl_xor(q, 1); q += __shfl_xor(q, 2);
              const float mean = s * (1.f / GWIDTH), var = fmaxf(q * (1.f / GWIDTH) - mean * mean, 0.f);
              if (part == 0) { MS[2 * r] = mean; MS[2 * r + 1] = 1.f / sqrtf(var + NORM_EPS); } }
            P2_BAR();
            {
#pragma unroll
              for (int p = 0; p < 8; ++p) { const int row = p * 16 + rr;
                  const v4u raw = vraw[p];
                  const float mean = MS[2 * row], rstd = MS[2 * row + 1];
                  f32x4 x0 = {bflo(raw.x), bfhi(raw.x), bflo(raw.y), bfhi(raw.y)}, x1 = {bflo(raw.z), bfhi(raw.z), bflo(raw.w), bfhi(raw.w)};
                  x0 = (x0 - mean) * rstd * g0 + b0; x1 = (x1 - mean) * rstd * g1 + b1;
                  v4u w; w.x = pg8::cvt_pk_bf16(x0[0], x0[1]); w.y = pg8::cvt_pk_bf16(x0[2], x0[3]); w.z = pg8::cvt_pk_bf16(x1[0], x1[1]); w.w = pg8::cvt_pk_bf16(x1[2], x1[3]);
                  *(LAS v4u*)(Tl + row * RS + cc * 16) = w; } }
            P2_BAR();
            if (uidx + G < 2048) P2_PREFETCH(uidx + G);
            v4u ur[8];
#pragma unroll
            for (int p = 0; p < 8; ++p) ur[p] = *(const v4u*)(Ub + (row0 + p * 16 + rr) * GWIDTH + g * 256 + cc * 8);
            f32x16 acc[4];
#pragma unroll
            for (int mt = 0; mt < 4; ++mt)
#pragma unroll
                for (int r = 0; r < 16; ++r) acc[mt][r] = 0.f;
#pragma unroll
            for (int ks = 0; ks < 8; ++ks) {
                const LAS unsigned short* bp = (const LAS unsigned short*)(Tl + (16 * ks + 8 * kg) * RS) + 32 * wave + j;
                bf16x8 bfr;
#pragma unroll
                for (int e = 0; e < 8; ++e) bfr[e] = (short)bp[e * (RS / 2)];
#pragma unroll
                for (int mt = 0; mt < 4; ++mt) if (ks <= 2 * mt + 1) {
                    const bf16x8 afr = *(const LAS bf16x8*)(WsL + (32 * mt + j) * WRS + (16 * ks + 8 * kg) * 2);
                    acc[mt] = __builtin_amdgcn_mfma_f32_32x32x16_bf16(bfr, afr, acc[mt], 0, 0, 0); }
                if (ks & 1) __builtin_amdgcn_sched_barrier(0);
            }
            P2_BAR();
#pragma unroll
            for (int mt = 0; mt < 4; ++mt) { const int tt = 32 * mt + j; const float bias = bsL[tt];
#pragma unroll
                for (int q = 0; q < 4; ++q) { typedef unsigned u32x2_t __attribute__((ext_vector_type(2)));
                    u32x2_t w; w.x = pg8::cvt_pk_bf16(acc[mt][4 * q] + bias, acc[mt][4 * q + 1] + bias); w.y = pg8::cvt_pk_bf16(acc[mt][4 * q + 2] + bias, acc[mt][4 * q + 3] + bias);
                    *(LAS u32x2_t*)(Tl + tt * RS + (32 * wave + 8 * q + 4 * kg) * 2) = w; } }
            P2_BAR();
#pragma unroll
            for (int p = 0; p < 8; ++p) { const int row = p * 16 + rr;
                bf16* up = Ub + (row0 + row) * GWIDTH + g * 256 + cc * 8;
                const v4u urp = ur[p]; const v4u mr = *(const LAS v4u*)(Tl + row * RS + cc * 16);
                v4u w; w.x = pg8::cvt_pk_bf16(bflo(urp.x) * bflo(mr.x), bfhi(urp.x) * bfhi(mr.x)); w.y = pg8::cvt_pk_bf16(bflo(urp.y) * bflo(mr.y), bfhi(urp.y) * bfhi(mr.y));
                w.z = pg8::cvt_pk_bf16(bflo(urp.z) * bflo(mr.z), bfhi(urp.z) * bfhi(mr.z)); w.w = pg8::cvt_pk_bf16(bflo(urp.w) * bflo(mr.w), bfhi(urp.w) * bfhi(mr.w));
                *(v4u*)up = w; }
            P2_BAR();
        }
#undef P2_PREFETCH
#undef P2_BAR
    }
#endif
    for (int rs_ = 0; rs_ < REP_SYNC; ++rs_) GRID_BAR();
#ifndef SKIP_P3
    for (int rep_ = 0; rep_ < REP_P3; ++rep_)
    { PHASE_BEGIN(); pg8::Gemm g{WSB_(WS_A + A_U), WSB_(WS_W + WO_OUT), MROWS, DMODEL, GWIDTH}; pg8::StaticOrder S; S.init(MROWS, DMODEL, G, bx);
      pg8::EpiRes<true, false> E{IN_(I_X), nullptr, nullptr, WSB_(WS_HB), WSF_(WS_RMS)};
      pg8::gemm_phase<pg8::EpiRes<true, false>, pg8::StaticOrder, true, true>(lds + RING_OFF, g, S, E); }
#endif
    for (int rs_ = 0; rs_ < REP_SYNC; ++rs_) GRID_BAR();
#ifndef SKIP_P4
    for (int rep_ = 0; rep_ < REP_P4; ++rep_)
    { PHASE_BEGIN(); pg8::Gemm g{WSB_(WS_HB), WSB_(WS_W + WO_GU0), MROWS, 2 * DFF, DMODEL}; pg8::StaticOrder S; S.init(MROWS, 2 * DFF, G, bx);
      pg8::EpiSwiglu E{WSB_(WS_A + A_ACT), WSF_(WS_RMS)};
      pg8::gemm_phase<pg8::EpiSwiglu, pg8::StaticOrder, true, true>(lds + RING_OFF, g, S, E); }
#endif
    for (int rs_ = 0; rs_ < REP_SYNC; ++rs_) GRID_BAR();
#ifndef SKIP_P5
    for (int rep_ = 0; rep_ < REP_P5; ++rep_)
    { PHASE_BEGIN(); pg8::Gemm g{WSB_(WS_A + A_ACT), WSB_(WS_W + WO_DN0), MROWS, DMODEL, DFF}; pg8::StaticOrder S; S.init(MROWS, DMODEL, G, bx);
      pg8::EpiRes<false, false> E{nullptr, WSB_(WS_HB), nullptr, WSB_(WS_HB), WSF_(WS_RMS)};
      pg8::gemm_phase<pg8::EpiRes<false, false>, pg8::StaticOrder, true, true>(lds + RING_OFF, g, S, E); }
#endif
    for (int rs_ = 0; rs_ < REP_SYNC; ++rs_) GRID_BAR();
#ifndef SKIP_P6
    for (int rep_ = 0; rep_ < REP_P6; ++rep_)
    { PHASE_BEGIN(); pg8::Gemm g{WSB_(WS_HB), WSB_(WS_W + WO_KVQ), MROWS, 3072, DMODEL}; pg8::StaticOrder S; S.init(MROWS, 3072, G, bx);
      pg8::EpiKVQ E{WSB_(WS_A + A_K), WSF_(WS_RMS), WSF_(WS_ROPE)};
      pg8::gemm_phase<pg8::EpiKVQ, pg8::StaticOrder, true, true>(lds + RING_OFF, g, S, E); }
#endif
    for (int rs_ = 0; rs_ < REP_SYNC; ++rs_) GRID_BAR();
#ifndef SKIP_P7
    for (int rep_ = 0; rep_ < REP_P7; ++rep_)
    { attn_body::attn_phase2<8>((char*)lds_raw + RING_OFF, WS_A + A_Q, WS_A + A_K, WS_A + A_VV, WS_A + A_O0, WS_A + A_AT, I_LAM_Q, I_LAM_K, I_SUB_G, G, vcu); }
#endif
    for (int rs_ = 0; rs_ < REP_SYNC; ++rs_) GRID_BAR();
#ifndef SKIP_P8
    for (int rep_ = 0; rep_ < REP_P8; ++rep_)
    { PHASE_BEGIN(); pg8::Gemm g{WSB_(WS_A + A_AT), WSB_(WS_W + WO_O), MROWS, DMODEL, DMODEL}; pg8::StaticOrder S; S.init(MROWS, DMODEL, G, bx);
      pg8::EpiRes<false, false> E{nullptr, WSB_(WS_HB), nullptr, WSB_(WS_HB), WSF_(WS_RMS)};
      pg8::gemm_phase<pg8::EpiRes<false, false>, pg8::StaticOrder, true, true>(lds + RING_OFF, g, S, E); }
#endif
    for (int rs_ = 0; rs_ < REP_SYNC; ++rs_) GRID_BAR();
#ifndef SKIP_P9
    for (int rep_ = 0; rep_ < REP_P9; ++rep_)
    { PHASE_BEGIN(); pg8::Gemm g{WSB_(WS_HB), WSB_(WS_W + WO_GU1), MROWS, 2 * DFF, DMODEL}; pg8::StaticOrder S; S.init(MROWS, 2 * DFF, G, bx);
      pg8::EpiSwiglu E{WSB_(WS_A + A_ACT), WSF_(WS_RMS)};
      pg8::gemm_phase<pg8::EpiSwiglu, pg8::StaticOrder, true, true>(lds + RING_OFF, g, S, E); }
#endif
    for (int rs_ = 0; rs_ < REP_SYNC; ++rs_) GRID_BAR();
#ifndef SKIP_P10
    for (int rep_ = 0; rep_ < REP_P10; ++rep_)
    { PHASE_BEGIN(); pg8::Gemm g{WSB_(WS_A + A_ACT), WSB_(WS_W + WO_DN1), MROWS, DMODEL, DFF}; pg8::StaticOrder S; S.init(MROWS, DMODEL, G, bx);
      pg8::EpiRes<false, false> E{nullptr, WSB_(WS_HB), nullptr, WSB_(WS_HB), WSF_(WS_RMS)};
      pg8::gemm_phase<pg8::EpiRes<false, false>, pg8::StaticOrder, true, true>(lds + RING_OFF, g, S, E); }
#endif
    for (int rs_ = 0; rs_ < REP_SYNC; ++rs_) GRID_BAR();
#ifndef SKIP_P11
    for (int rep_ = 0; rep_ < REP_P11; ++rep_)
    {
        PHASE_BEGIN(); const int gw = vcu * NWAVES + wave; float* out = A_->out; const float* rms = WSF_(WS_RMS); const bf16* HB = WSB_(WS_HB);
        const float* gp = IN_(I_FINAL_G) + lane * 16;
        f32x4 gv[4];
#pragma unroll
        for (int j = 0; j < 4; ++j) gv[j] = *(const f32x4*)(gp + 4 * j);
        for (int m0 = gw; m0 < MROWS; m0 += 8 * NGW) {
            v4u a[8][2]; float rs[8];
#pragma unroll
            for (int k = 0; k < 8; ++k) { const int m = (m0 + k * NGW < MROWS) ? m0 + k * NGW : m0; const v4u* p = (const v4u*)(HB + (size_t)m * DMODEL + lane * 16); a[k][0] = p[0]; a[k][1] = p[1]; }
#pragma unroll
            for (int k = 0; k < 8; ++k) { const int m = (m0 + k * NGW < MROWS) ? m0 + k * NGW : m0; rs[k] = pg8::row_rstd(rms, m); }
#pragma unroll
            for (int k = 0; k < 8; ++k) { const int m = m0 + k * NGW; if (m < MROWS) { const float rstd = rs[k]; const v4u a0 = a[k][0], a1 = a[k][1];
                f32x4* o = (f32x4*)(out + (size_t)m * DMODEL + lane * 16);
                o[0] = (f32x4){bflo(a0.x), bfhi(a0.x), bflo(a0.y), bfhi(a0.y)} * rstd * gv[0]; o[1] = (f32x4){bflo(a0.z), bfhi(a0.z), bflo(a0.w), bfhi(a0.w)} * rstd * gv[1];
                o[2] = (f32x4){bflo(a1.x), bfhi(a1.x), bflo(a1.y), bfhi(a1.y)} * rstd * gv[2]; o[3] = (f32x4){bflo(a1.z), bfhi(a1.z), bflo(a1.w), bfhi(a1.w)} * rstd * gv[3]; } }
        }
    }
#endif
}

extern "C" void kernel_launch(void* const* d_in, const int* in_sizes, int n_in, void* d_out, int out_size, void* d_ws, size_t ws_size, hipStream_t stream) {
    static int grid = 0;
    if (grid == 0) {
        if (n_in != 19 || in_sizes[0] != MROWS * DMODEL || out_size != MROWS * DMODEL || ws_size < WS_END) { fprintf(stderr, "kernel_launch: unexpected problem shape (n_in %d, in0 %d, out %d, ws %zu); nothing launched\n", n_in, n_in > 0 ? in_sizes[0] : -1, out_size, ws_size); grid = -1; return; }
        int dev = 0, cus = 0, per_cu = 0;
        if (hipGetDevice(&dev) != hipSuccess || hipDeviceGetAttribute(&cus, hipDeviceAttributeMultiprocessorCount, dev) != hipSuccess) { fprintf(stderr, "kernel_launch: device query failed\n"); grid = -1; return; }
        if (hipFuncSetAttribute((const void*)mk_fwd, hipFuncAttributeMaxDynamicSharedMemorySize, LDS_BYTES) != hipSuccess) { fprintf(stderr, "kernel_launch: hipFuncSetAttribute failed\n"); grid = -1; return; }
        if (hipOccupancyMaxActiveBlocksPerMultiprocessor(&per_cu, (const void*)mk_fwd, NWAVES * 64, LDS_BYTES) != hipSuccess || per_cu < 1) { fprintf(stderr, "kernel_launch: occupancy query gave %d\n", per_cu); per_cu = 1; }
        (void)hipGetLastError();
        grid = cus * per_cu;
    }
    if (grid < 0) return;
    Args a{};
    for (int i = 0; i < 19; ++i) a.in[i] = (const float*)d_in[i];
    a.out = (float*)d_out; a.ws = (unsigned char*)d_ws;
    void* kargs[] = {&a};
    const hipError_t e = hipLaunchCooperativeKernel((const void*)mk_fwd, dim3(grid), dim3(NWAVES * 64), kargs, LDS_BYTES, stream);
    if (e != hipSuccess) fprintf(stderr, "kernel_launch: cooperative launch failed: %s (grid %d)\n", hipGetErrorString(e), grid);
}
```
